# Optimizing an MI355X kernel written in HIP

```python
import math, functools
import jax, jax.numpy as jnp
from jax import lax
import numpy as np

D_MODEL = 1024
BATCH = 8
SEQ = 2048
DEPTH = 4
DEC_BATCH = 8
DEC_SEQ = 16
PAST_LEN = 2048

CHUNK = 64
Q_BLOCK = 128
EPS = 1e-6
ROPE_THETA = 10000.0
NEG = -1e30

A_HEADS = 8
A_KV_HEADS = 2
A_HEAD_DIM = 64
IDX_HEADS = 8
IDX_DIM = 64
TOPK_MAX = 256
B_HEADS = 8
B_HEAD_DIM = 64
P_HEADS = 8
N_KEYS = 128
N_EXPERTS = N_KEYS * N_KEYS
P_KEY_DIM = 128
P_HALF = P_KEY_DIM // 2
P_TOPK = 16
PEER_BLOCK = 128

W_QA = A_HEADS * A_HEAD_DIM
W_KA = A_KV_HEADS * A_HEAD_DIM
W_VA = A_KV_HEADS * A_HEAD_DIM
W_QI = IDX_HEADS * IDX_DIM
W_KI = IDX_DIM
W_WI = IDX_HEADS
W_QB = B_HEADS * B_HEAD_DIM
W_KB = B_HEADS * B_HEAD_DIM
W_VB = B_HEADS * B_HEAD_DIM
W_G = D_MODEL
SPLITS = (W_QA, W_KA, W_VA, W_QI, W_KI, W_WI, W_QB, W_KB, W_VB, W_G, W_G)
N_IN = W_QA + W_KA + W_VA + W_QI + W_KI + W_WI + W_QB + W_KB + W_VB + 2 * W_G

kernel_name = 'hybrid_dsa_stickbreak_peer_stream'


def _rms(x, g):
    xf = x.astype(jnp.float32)
    y = xf * lax.rsqrt(jnp.mean(xf * xf, axis=-1, keepdims=True) + EPS)
    return (y * g.astype(jnp.float32)).astype(x.dtype)


def _rope(x, pos):
    half = x.shape[-1] // 2
    inv = ROPE_THETA ** (-jnp.arange(half, dtype=jnp.float32) / half)
    ang = pos.astype(jnp.float32)[:, None] * inv[None, :]
    cos = jnp.cos(ang)[None, :, None, :]
    sin = jnp.sin(ang)[None, :, None, :]
    xf = x.astype(jnp.float32)
    x1, x2 = xf[..., :half], xf[..., half:]
    return jnp.concatenate([x1 * cos - x2 * sin, x2 * cos + x1 * sin], axis=-1).astype(x.dtype)


def _split_cols(p):
    outs = []
    start = 0
    for w in SPLITS:
        outs.append(p[..., start:start + w])
        start += w
    return outs


def _sweep(fn, qs, q_pos):
    T = q_pos.shape[0]
    if T % Q_BLOCK != 0:
        return fn(qs, q_pos)
    nb = T // Q_BLOCK

    def blk(a):
        return jnp.moveaxis(a.reshape((a.shape[0], nb, Q_BLOCK) + a.shape[2:]), 1, 0)

    out = lax.map(lambda args: fn(args[0], args[1]),
                  (tuple(blk(a) for a in qs), q_pos.reshape(nb, Q_BLOCK)))
    out = jnp.moveaxis(out, 0, 1)
    return out.reshape((out.shape[0], T) + out.shape[3:])


def _dsa_block(qs, q_pos, k, v, ki, k_pos, topk):
    q, qi, wi = qs
    B, Q = q.shape[0], q.shape[1]
    f32 = jnp.float32
    isc = jnp.einsum('bqhd,bsd->bqhs', qi.astype(f32), ki.astype(f32)) * (IDX_DIM ** -0.5)
    isc = jnp.einsum('bqhs,bqh->bqs', jax.nn.relu(isc), wi.astype(f32) * (IDX_HEADS ** -0.5))
    adm = (k_pos[None, :] // CHUNK) <= (q_pos[:, None] // CHUNK)
    isc = jnp.where(adm[None], isc, NEG)
    _, idx = lax.top_k(isc, topk)
    valid = (k_pos[idx] // CHUNK) <= (q_pos[None, :, None] // CHUNK)
    k_sel = jax.vmap(lambda kb, ib: kb[ib])(k, idx)
    v_sel = jax.vmap(lambda vb, ib: vb[ib])(v, idx)
    qg = q.reshape(B, Q, A_KV_HEADS, A_HEADS // A_KV_HEADS, A_HEAD_DIM).astype(f32)
    s = jnp.einsum('bqngd,bqknd->bqngk', qg, k_sel.astype(f32)) * (A_HEAD_DIM ** -0.5)
    s = jnp.where(valid[:, :, None, None, :], s, NEG)
    p = jax.nn.softmax(s, axis=-1)
    o = jnp.einsum('bqngk,bqknd->bqngd', p, v_sel.astype(f32))
    return o.reshape(B, Q, A_HEADS * A_HEAD_DIM).astype(q.dtype)


def _sb_block(qs, q_pos, k, v, k_pos):
    q = qs[0]
    B, Q = q.shape[0], q.shape[1]
    f32 = jnp.float32
    z = jnp.einsum('bqhd,bshd->bhqs', q.astype(f32), k.astype(f32)) * (B_HEAD_DIM ** -0.5)
    before = (k_pos[None, :] < q_pos[:, None])[None, None]
    log_rest = jnp.where(before, jax.nn.log_sigmoid(-z), 0.0)
    after = lax.cumsum(log_rest, axis=3, reverse=True) - log_rest
    att = jnp.where(before, jnp.exp(jax.nn.log_sigmoid(z) + after), 0.0)
    o = jnp.einsum('bhqs,bshd->bqhd', att, v.astype(f32))
    return o.reshape(B, Q, B_HEADS * B_HEAD_DIM).astype(q.dtype)


def _peer(h, w_pq, k1, k2, u_tab, v_tab):
    B, T, D = h.shape
    n = B * T
    xf = h.reshape(n, D)
    f32 = jnp.float32

    def one(xb):
        m = xb.shape[0]
        q = (xb @ w_pq).reshape(m, P_HEADS, 2, P_HALF).astype(f32)
        s1 = jnp.einsum('nhd,hkd->nhk', q[:, :, 0], k1.astype(f32))
        s2 = jnp.einsum('nhd,hkd->nhk', q[:, :, 1], k2.astype(f32))
        v1, i1 = lax.top_k(s1, P_TOPK)
        v2, i2 = lax.top_k(s2, P_TOPK)
        cand = (v1[..., :, None] + v2[..., None, :]).reshape(m, P_HEADS, P_TOPK * P_TOPK)
        cid = (i1[..., :, None] * N_KEYS + i2[..., None, :]).reshape(m, P_HEADS, P_TOPK * P_TOPK)
        sc, pick = lax.top_k(cand, P_TOPK)
        eid = jnp.take_along_axis(cid, pick, axis=-1)
        g = jax.nn.softmax(sc, axis=-1)
        u = u_tab[eid]
        a = jax.nn.gelu(jnp.einsum('nhkd,nd->nhk', u, xb).astype(f32), approximate=False)
        coef = (g * a).astype(xb.dtype)
        return jnp.einsum('nhk,nhkd->nd', coef, v_tab[eid])

    if n % PEER_BLOCK != 0:
        out = one(xf)
    else:
        out = lax.map(one, xf.reshape(n // PEER_BLOCK, PEER_BLOCK, D)).reshape(n, D)
    return out.reshape(B, T, D)


def _layer(x, pos, past, lw, topk):
    (n1, w_in, qn, kn, ikn, w_pa, w_pb, w_o, n2, pwq, pk1, pk2, pu, pv) = lw
    B, T, _ = x.shape
    h = _rms(x, n1)
    qa, ka, va, qi, ki, wi, qb, kb, vb, ga, gb = _split_cols(h @ w_in)
    qa = _rope(_rms(qa.reshape(B, T, A_HEADS, A_HEAD_DIM), qn), pos)
    ka = _rope(_rms(ka.reshape(B, T, A_KV_HEADS, A_HEAD_DIM), kn), pos)
    va = va.reshape(B, T, A_KV_HEADS, A_HEAD_DIM)
    qi = _rope(qi.reshape(B, T, IDX_HEADS, IDX_DIM), pos)
    ki = _rope(_rms(ki, ikn)[:, :, None, :], pos)[:, :, 0, :]
    qb = qb.reshape(B, T, B_HEADS, B_HEAD_DIM)
    kb = kb.reshape(B, T, B_HEADS, B_HEAD_DIM)
    vb = vb.reshape(B, T, B_HEADS, B_HEAD_DIM)
    new = (ka, va, ki, kb, vb)
    if past is None:
        ka_all, va_all, ki_all, kb_all, vb_all = new
        k_pos = pos
    else:
        ka_all = jnp.concatenate([past[0], ka], axis=1)
        va_all = jnp.concatenate([past[1], va], axis=1)
        ki_all = jnp.concatenate([past[2], ki], axis=1)
        kb_all = jnp.concatenate([past[3], kb], axis=1)
        vb_all = jnp.concatenate([past[4], vb], axis=1)
        k_pos = jnp.arange(ka_all.shape[1], dtype=jnp.int32)
    oa = _sweep(lambda qs, qp: _dsa_block(qs, qp, ka_all, va_all, ki_all, k_pos, topk),
                (qa, qi, wi), pos)
    ob = _sweep(lambda qs, qp: _sb_block(qs, qp, kb_all, vb_all, k_pos), (qb,), pos)
    m = jax.nn.sigmoid(ga) * (oa @ w_pa) + jax.nn.sigmoid(gb) * (ob @ w_pb)
    x = x + m @ w_o
    x = x + _peer(_rms(x, n2), pwq, pk1, pk2, pu, pv)
    return x, new


def setup_inputs(seed: int = 0) -> dict:
    key = jax.random.key(seed)
    ks = jax.random.split(key, 24)
    f32 = jnp.float32

    def nrm(k, shape, scale):
        return jax.random.normal(k, shape, f32) * scale

    def gain(k, shape):
        return 1.0 + 0.02 * jax.random.normal(k, shape, f32)

    return {
        'x_prompt': nrm(ks[0], (BATCH, SEQ, D_MODEL), 1.0),
        'x_sample': nrm(ks[1], (DEC_BATCH, DEC_SEQ, D_MODEL), 1.0),
        'cache_a_k': nrm(ks[2], (DEPTH, DEC_BATCH, PAST_LEN, A_KV_HEADS, A_HEAD_DIM), 1.0),
        'cache_a_v': nrm(ks[3], (DEPTH, DEC_BATCH, PAST_LEN, A_KV_HEADS, A_HEAD_DIM), 0.5),
        'cache_idx_k': nrm(ks[4], (DEPTH, DEC_BATCH, PAST_LEN, IDX_DIM), 1.0),
        'cache_b_k': nrm(ks[5], (DEPTH, DEC_BATCH, PAST_LEN, B_HEADS, B_HEAD_DIM), 1.0),
        'cache_b_v': nrm(ks[6], (DEPTH, DEC_BATCH, PAST_LEN, B_HEADS, B_HEAD_DIM), 0.5),
        'norm1': gain(ks[7], (DEPTH, D_MODEL)),
        'w_in': nrm(ks[8], (DEPTH, D_MODEL, N_IN), D_MODEL ** -0.5),
        'q_norm_a': gain(ks[9], (DEPTH, A_HEAD_DIM)),
        'k_norm_a': gain(ks[10], (DEPTH, A_HEAD_DIM)),
        'idx_k_norm': gain(ks[11], (DEPTH, IDX_DIM)),
        'w_pa': nrm(ks[12], (DEPTH, W_QA, D_MODEL), W_QA ** -0.5),
        'w_pb': nrm(ks[13], (DEPTH, W_QB, D_MODEL), W_QB ** -0.5),
        'w_o': nrm(ks[14], (DEPTH, D_MODEL, D_MODEL), D_MODEL ** -0.5),
        'norm2': gain(ks[15], (DEPTH, D_MODEL)),
        'peer_wq': nrm(ks[16], (DEPTH, D_MODEL, P_HEADS * P_KEY_DIM), D_MODEL ** -0.5),
        'peer_k1': nrm(ks[17], (DEPTH, P_HEADS, N_KEYS, P_HALF), P_HALF ** -0.5),
        'peer_k2': nrm(ks[18], (DEPTH, P_HEADS, N_KEYS, P_HALF), P_HALF ** -0.5),
        'peer_u': nrm(ks[19], (DEPTH, N_EXPERTS, D_MODEL), D_MODEL ** -0.5),
        'peer_v': nrm(ks[20], (DEPTH, N_EXPERTS, D_MODEL), (P_HEADS * P_TOPK) ** -0.5),
    }


def reference(x_prompt, x_sample, cache_a_k, cache_a_v, cache_idx_k, cache_b_k, cache_b_v,
              norm1, w_in, q_norm_a, k_norm_a, idx_k_norm, w_pa, w_pb, w_o, norm2,
              peer_wq, peer_k1, peer_k2, peer_u, peer_v):
    t_p = x_prompt.shape[1]
    t_s = x_sample.shape[1]
    past_len = cache_a_k.shape[2]
    pos_p = jnp.arange(t_p, dtype=jnp.int32)
    pos_s = past_len + jnp.arange(t_s, dtype=jnp.int32)
    topk_p = min(TOPK_MAX, t_p // 4)
    topk_s = min(TOPK_MAX, (past_len + t_s) // 4)
    xp, xs = x_prompt, x_sample
    st_p, st_s = [], []
    for l in range(DEPTH):
        lw = (norm1[l], w_in[l], q_norm_a[l], k_norm_a[l], idx_k_norm[l], w_pa[l], w_pb[l],
              w_o[l], norm2[l], peer_wq[l], peer_k1[l], peer_k2[l], peer_u[l], peer_v[l])
        xp, sp = _layer(xp, pos_p, None, lw, topk_p)
        past = (cache_a_k[l], cache_a_v[l], cache_idx_k[l], cache_b_k[l], cache_b_v[l])
        xs, ss = _layer(xs, pos_s, past, lw, topk_s)
        st_p.append(sp)
        st_s.append(ss)
    a_k_p = jnp.stack([s[0] for s in st_p])
    a_v_p = jnp.stack([s[1] for s in st_p])
    idx_k_p = jnp.stack([s[2] for s in st_p])
    b_k_p = jnp.stack([s[3] for s in st_p])
    b_v_p = jnp.stack([s[4] for s in st_p])
    a_k_s = jnp.stack([s[0] for s in st_s])
    a_v_s = jnp.stack([s[1] for s in st_s])
    idx_k_s = jnp.stack([s[2] for s in st_s])
    b_k_s = jnp.stack([s[3] for s in st_s])
    b_v_s = jnp.stack([s[4] for s in st_s])
    return (xp, xs, a_k_p, a_v_p, idx_k_p, b_k_p, b_v_p, a_k_s, a_v_s, idx_k_s, b_k_s, b_v_s)
```

```cpp
#include <hip/hip_runtime.h>
#include <cstdio>
#include <cstdint>
namespace pg8 {
#define PG8_LAS __attribute__((address_space(3)))
typedef unsigned short bf16_t;
typedef short bf16x8 __attribute__((ext_vector_type(8)));
typedef float f32x4 __attribute__((ext_vector_type(4)));
typedef unsigned u32x4 __attribute__((ext_vector_type(4)));
constexpr int BM = 256, BK = 64, HALF = 128, HTB = HALF * BK * 2  , STAGE_BYTES = 8 * HTB, NXCD = 8, WGM = 8;

__host__ __device__ __forceinline__ int lds_byte(int r, int c) { const int st = (r >> 4) * 2 + (c >> 5), rr = r & 15, cc = c & 31, ob = rr * 64 + cc * 2; return st * 1024 + (ob ^ (((ob >> 9) & 1) << 5)); }
__host__ __device__ __forceinline__ void stage_rc(int b, int& R, int& C) { const int st = b / 1024, sb = b % 1024, swz = sb ^ (((sb >> 9) & 1) << 5); R = (st >> 1) * 16 + swz / 64; C = (st & 1) * 32 + (swz % 64) / 2; }
__host__ __device__ __forceinline__ int perm32(int rho) { const int n = rho >> 4, i = rho & 15; return 8 * (i >> 2) + 4 * n + (i & 3); }

struct Unit { int pm, pn; };
struct Gemm { const bf16_t* A; const bf16_t* Bt; int M, N, K; };

struct StaticOrder {
    int nM, nN, nwg, G, c;
    __host__ __device__ void init(int M, int N, int G_, int c_) { nM = M / BM; nN = N / BM; nwg = nM * nN; G = G_; c = c_; }
    __host__ __device__ bool next(int i, Unit& u) const {
        const long L = (long)i * G + c; if (L >= nwg) return false;
        int wgid = (int)L; { const int q = nwg / NXCD, r = nwg % NXCD, xcd = wgid % NXCD, off = wgid / NXCD; wgid = (xcd < r ? xcd * (q + 1) : r * (q + 1) + (xcd - r) * q) + off; }
        const int nig = WGM * nN, gid = wgid / nig, fm = gid * WGM, gsz = (nM - fm) < WGM ? (nM - fm) : WGM;
        u.pm = fm + ((wgid % nig) % gsz); u.pn = (wgid % nig) / gsz; return true;
    }
    __device__ __forceinline__ void a_ready(const Unit&) const {}
    __device__ __forceinline__ void done(const Unit&) const {}
};
__device__ __forceinline__ unsigned cvt_pk_bf16(float lo, float hi) { unsigned r; asm volatile("v_cvt_pk_bf16_f32 %0, %1, %2" : "=v"(r) : "v"(lo), "v"(hi)); return r; }
template <class Epi, class Sched, bool STAMP = false>
__device__ __forceinline__ void gemm_phase(PG8_LAS unsigned char* lds, const Gemm g, const Sched& S, const Epi& E, unsigned long long* stamps) {
    int tid_l = threadIdx.x; asm volatile("" : "+v"(tid_l));
    const int tid = tid_l, wid = __builtin_amdgcn_readfirstlane(tid >> 6), lane = tid & 63, wr = wid >> 2, wc = wid & 3, fr = lane & 15, fq = lane >> 4;
    const int K = g.K, nt = K / BK;
    int ts_lo = 0, ts_hi = 0, nts = 0; const unsigned long long rt_entry = STAMP ? (unsigned long long)wall_clock64() : 0ull;
#define PG8_STAMP() do { if (STAMP && wid == 0 && nts < 64) { const unsigned long long _c = (unsigned long long)clock64(); \
        ts_lo = (lane == nts) ? (int)(unsigned)_c : ts_lo; ts_hi = (lane == nts) ? (int)(unsigned)(_c >> 32) : ts_hi; ++nts; } } while (0)
    PG8_STAMP();
    unsigned voffA[2], voffB[2];
#pragma unroll
    for (int i = 0; i < 2; ++i) { int R, C; stage_rc(tid * 16 + i * 8192, R, C); const int Rb = Epi::PERM ? ((R & ~31) + perm32(R & 31)) : R;
        voffA[i] = (unsigned)(R * K + C) * 2u; voffB[i] = (unsigned)(Rb * K + C) * 2u; }
    const size_t kstep = (size_t)(BK * 2);
    const size_t hstep = (size_t)HALF * K * 2;
    const size_t tstep = 2 * hstep;
    const unsigned ldsw = (unsigned)wid * 1024u;
    const int aoff = lds_byte(wr * 64 + fr, fq * 8), boff = lds_byte(wc * 32 + fr, fq * 8);
#define PG8_SA(b, h) (((b) * 2 + (h)) * HTB)
#define PG8_SB(b, h) ((4 + (b) * 2 + (h)) * HTB)
#define PG8_STAGE(bufoff, gbase, voff) do { _Pragma("unroll") for (int _i = 0; _i < 2; ++_i) \
        __builtin_amdgcn_global_load_lds((const unsigned*)((const char*)(gbase) + (voff)[_i]), (PG8_LAS unsigned*)(lds + (bufoff) + ldsw + _i * 8192), 16, 0, 0); } while (0)
#define PG8_LDA(dst, b, h) do { _Pragma("unroll") for (int m = 0; m < 4; ++m) _Pragma("unroll") for (int k = 0; k < 2; ++k) dst[m][k] = *(const PG8_LAS bf16x8*)(lds + PG8_SA(b, h) + aoff + m * 2048 + k * 1024); } while (0)
#define PG8_LDB(dst, b, h) do { _Pragma("unroll") for (int n = 0; n < 2; ++n) _Pragma("unroll") for (int k = 0; k < 2; ++k) dst[n][k] = *(const PG8_LAS bf16x8*)(lds + PG8_SB(b, h) + boff + n * 2048 + k * 1024); } while (0)
#define PG8_MMA(ai, bj, At, Bt) do { __builtin_amdgcn_s_setprio(1); _Pragma("unroll") for (int m = 0; m < 4; ++m) _Pragma("unroll") for (int n = 0; n < 2; ++n) _Pragma("unroll") for (int k = 0; k < 2; ++k) \
        acc[ai][bj][m][n] = __builtin_amdgcn_mfma_f32_16x16x32_bf16(Bt[n][k], At[m][k], acc[ai][bj][m][n], 0, 0, 0); __builtin_amdgcn_s_setprio(0); } while (0)
#define PG8_WAIT_V(n) asm volatile("s_waitcnt vmcnt(" #n ")" ::: "memory")
#define PG8_WAIT_L(n) asm volatile("s_waitcnt lgkmcnt(" #n ")" ::: "memory")
#define PG8_BAR __builtin_amdgcn_s_barrier()
#define PG8_SCHED __builtin_amdgcn_sched_barrier(0)
    Unit cur, nxt; int ui = 0;
    if (!S.next(0, cur)) return;
    f32x4 acc[2][2][4][2];
#pragma unroll
    for (int a = 0; a < 2; ++a)
#pragma unroll
        for (int b = 0; b < 2; ++b)
#pragma unroll
            for (int m = 0; m < 4; ++m)
#pragma unroll
                for (int n = 0; n < 2; ++n) acc[a][b][m][n] = (f32x4){0.f, 0.f, 0.f, 0.f};
    bf16x8 At[4][2], B0[2][2], B1[2][2];
    const char* cA = (const char*)g.A + (size_t)cur.pm * tstep; const char* cB = (const char*)g.Bt + (size_t)cur.pn * tstep;
    S.a_ready(cur);
    PG8_STAGE(PG8_SB(0, 0), cB, voffB); PG8_STAGE(PG8_SA(0, 0), cA, voffA); PG8_STAGE(PG8_SB(0, 1), cB + hstep, voffB); PG8_STAGE(PG8_SA(0, 1), cA + hstep, voffA);
    if (wr == 1) PG8_BAR;
    PG8_WAIT_V(4); PG8_BAR;
    PG8_STAGE(PG8_SB(1, 0), cB + kstep, voffB); PG8_STAGE(PG8_SA(1, 0), cA + kstep, voffA); PG8_STAGE(PG8_SB(1, 1), cB + hstep + kstep, voffB);
    PG8_WAIT_V(6); PG8_BAR;
    PG8_STAMP();
    for (;;) {
        const bool has_next = S.next(ui + 1, nxt);
        const char* nA = has_next ? (const char*)g.A + (size_t)nxt.pm * tstep : cA; const char* nB = has_next ? (const char*)g.Bt + (size_t)nxt.pn * tstep : cB;
        for (int t = 0; t < nt; t += 2) {
            const bool last = (t == nt - 2);
            const char* a1 = cA + (size_t)(t + 1) * kstep;
            const char* a2 = last ? nA : cA + (size_t)(t + 2) * kstep; const char* b2 = last ? nB : cB + (size_t)(t + 2) * kstep;
            const char* a3 = a2 + kstep; const char* b3 = b2 + kstep;
            if (last && has_next) S.a_ready(nxt);
            PG8_LDB(B0, 0, 0); PG8_SCHED; PG8_LDA(At, 0, 0); PG8_STAGE(PG8_SA(1, 1), a1 + hstep, voffA);
            PG8_WAIT_L(8); PG8_BAR; PG8_WAIT_L(0); PG8_MMA(0, 0, At, B0); PG8_BAR; PG8_SCHED;
            PG8_LDB(B1, 0, 1); PG8_STAGE(PG8_SB(0, 0), b2, voffB);
            PG8_BAR; PG8_WAIT_L(0); PG8_MMA(0, 1, At, B1); PG8_BAR;
            PG8_LDA(At, 0, 1); PG8_STAGE(PG8_SA(0, 0), a2, voffA);
            PG8_BAR; PG8_WAIT_L(0); PG8_MMA(1, 0, At, B0); PG8_BAR; PG8_SCHED;
            PG8_STAGE(PG8_SB(0, 1), b2 + hstep, voffB);
            PG8_WAIT_V(6); PG8_BAR; PG8_MMA(1, 1, At, B1); PG8_BAR;
            PG8_LDB(B0, 1, 0); PG8_SCHED; PG8_LDA(At, 1, 0); PG8_STAGE(PG8_SA(0, 1), a2 + hstep, voffA);
            PG8_WAIT_L(8); PG8_BAR; PG8_WAIT_L(0); PG8_MMA(0, 0, At, B0); PG8_BAR; PG8_SCHED;
            PG8_LDB(B1, 1, 1); PG8_STAGE(PG8_SB(1, 0), b3, voffB);
            PG8_BAR; PG8_WAIT_L(0); PG8_MMA(0, 1, At, B1); PG8_BAR;
            PG8_LDA(At, 1, 1); PG8_STAGE(PG8_SA(1, 0), a3, voffA);
            PG8_BAR; PG8_WAIT_L(0); PG8_MMA(1, 0, At, B0); PG8_BAR; PG8_SCHED;
            PG8_STAGE(PG8_SB(1, 1), b3 + hstep, voffB);
            PG8_WAIT_V(6); PG8_BAR; PG8_MMA(1, 1, At, B1); PG8_BAR;
        }
        PG8_STAMP();
        if constexpr (!Epi::AFTER_DRAIN) { E(acc, cur, wr, wc, fr, fq); S.done(cur); }
        PG8_STAMP();
        if (!has_next) break;
#pragma unroll
        for (int a = 0; a < 2; ++a)
#pragma unroll
            for (int b = 0; b < 2; ++b)
#pragma unroll
                for (int m = 0; m < 4; ++m)
#pragma unroll
                    for (int n = 0; n < 2; ++n) acc[a][b][m][n] = (f32x4){0.f, 0.f, 0.f, 0.f};
        cur = nxt; cA = nA; cB = nB; ++ui;
    }
    PG8_WAIT_V(0);
    if (wr == 0) PG8_BAR;
    PG8_BAR;
    if constexpr (Epi::AFTER_DRAIN) { E.fused(acc, cur, wr, wc, fr, fq, lds, wid, lane); S.done(cur); }
    PG8_STAMP();
    if (STAMP && wid == 0) { stamps[lane] = lane < nts ? (((unsigned long long)(unsigned)ts_hi << 32) | (unsigned)ts_lo) : 0ull;
        if (lane == 62) stamps[62] = rt_entry; if (lane == 63) stamps[63] = (unsigned long long)wall_clock64(); }
#undef PG8_STAMP
#undef PG8_SA
#undef PG8_SB
#undef PG8_STAGE
#undef PG8_LDA
#undef PG8_LDB
#undef PG8_MMA
#undef PG8_WAIT_V
#undef PG8_WAIT_L
#undef PG8_BAR
#undef PG8_SCHED
}
}
#define XB_TMO      128
#define XB_XCNT(j)  (256  + 64 * (j))
#define XB_XSUB(j)  (1280 + 64 * (j))
#define XB_XGEN(j)  (2304 + 64 * (j))
#define XB_TOP      3328
#define XB_TOPGEN   3392
#define XCD_BAR_WORDS 3456
#define XB_SPIN_CAP (1u << 18)
#define LAS __attribute__((address_space(3)))

__device__ __forceinline__ unsigned xb_ld(unsigned* p)              { return __hip_atomic_load(p, __ATOMIC_RELAXED, __HIP_MEMORY_SCOPE_AGENT); }
__device__ __forceinline__ unsigned xb_add(unsigned* p, unsigned v) { return __hip_atomic_fetch_add(p, v, __ATOMIC_RELAXED, __HIP_MEMORY_SCOPE_AGENT); }
__device__ __forceinline__ unsigned xb_xcc_id() { return (unsigned)__builtin_amdgcn_s_getreg((3 << 11) | 20) & 0xFu; }
#define XB_SPIN(cond, bar) do { unsigned _sp = 0; while (cond) { __builtin_amdgcn_s_sleep(1); \
    if ((++_sp & 255u) == 0u) { if (xb_ld(&(bar)[XB_TMO])) break; if (_sp > XB_SPIN_CAP) { atomicAdd(&(bar)[XB_TMO], 1u); break; } } } } while (0)

struct XcdBarrier {
    unsigned* bar; unsigned x;
    volatile LAS unsigned* st;
};

__device__ __forceinline__ XcdBarrier xcd_barrier_post(unsigned* bar, volatile LAS unsigned* st) {
    XcdBarrier b; b.bar = bar; b.x = xb_xcc_id(); b.st = st;
    if (threadIdx.x == 0) (void)xb_add(&bar[XB_XCNT(b.x)], 1u);
    return b;
}
__device__ __forceinline__ void xcd_barrier_complete(unsigned* bar, unsigned x, unsigned& nloc, unsigned& nx) {
    const unsigned G = gridDim.x * gridDim.y * gridDim.z;
    unsigned sum, cnt, mine, sp = 0u;
    for (;;) {
        sum = 0u; cnt = 0u; mine = 0u;
#pragma unroll
        for (unsigned j = 0; j < 16; ++j) { const unsigned c = xb_ld(&bar[XB_XCNT(j)]); sum += c; cnt += (c > 0u) ? 1u : 0u; mine = (j == x) ? c : mine; }
        if (sum == G) break;
        __builtin_amdgcn_s_sleep(1);
        if ((++sp & 255u) == 0u) { if (xb_ld(&bar[XB_TMO])) break; if (sp > XB_SPIN_CAP) { atomicAdd(&bar[XB_TMO], 1u); break; } }
    }
    nloc = mine > 0u ? mine : 1u; nx = cnt > 0u ? cnt : 1u;
}

__device__ __forceinline__ void xcd_barrier(const XcdBarrier& b) {
    asm volatile("s_waitcnt vmcnt(0)" ::: "memory");
    __syncthreads();
    if (threadIdx.x == 0) {
        unsigned* bar = b.bar;
        __builtin_amdgcn_s_waitcnt(0);
        unsigned nloc = b.st[0], nx = b.st[1];
        if (nloc == 0u) { xcd_barrier_complete(bar, b.x, nloc, nx); b.st[0] = nloc; b.st[1] = nx; }
        const unsigned old = xb_add(&bar[XB_XSUB(b.x)], 1u);
        const unsigned gen = old / nloc;
        if (old + 1u == (gen + 1u) * nloc) {
            __builtin_amdgcn_fence(__ATOMIC_RELEASE, "agent");
            asm volatile("s_waitcnt vmcnt(0)" ::: "memory");
            const unsigned og = xb_add(&bar[XB_TOP], 1u);
            const unsigned tg = og / nx;
            if (og + 1u == (tg + 1u) * nx) xb_add(&bar[XB_TOPGEN], 1u);
            else XB_SPIN(xb_ld(&bar[XB_TOPGEN]) == tg, bar);
            __builtin_amdgcn_fence(__ATOMIC_ACQUIRE, "agent");
            xb_add(&bar[XB_XGEN(b.x)], 1u);
            asm volatile("s_waitcnt vmcnt(0)" ::: "memory");
        } else {
            XB_SPIN(xb_ld(&bar[XB_XGEN(b.x)]) == gen, bar);
            __builtin_amdgcn_fence(__ATOMIC_ACQUIRE, "agent");
            asm volatile("s_waitcnt vmcnt(0)" ::: "memory");
        }
    }
    __syncthreads();
}

namespace mk {
using pg8::bf16_t; using pg8::bf16x8; using pg8::f32x4;
typedef unsigned u32x2v __attribute__((ext_vector_type(2)));

constexpr int D = 1024, NB = 8, SEQ = 2048, DEPTH = 4, DSEQ = 16, PAST = 2048, SKEYS = PAST + DSEQ;
constexpr int MP = NB * SEQ, MS = NB * DSEQ, MT = MP + MS;
constexpr int NIN = 4936, NINP = 5120;
constexpr int C_QA = 0, C_KA = 512, C_VA = 640, C_QI = 768, C_KI = 1280, C_WI = 1344, C_QB = 1352, C_KB = 1864, C_VB = 2376, C_GA = 2888, C_GB = 3912;
constexpr int NEXP = 16384, TOPK = 256;
constexpr float EPS = 1e-6f;

constexpr size_t O_YP = 0, O_YS = O_YP + (size_t)MP * D, O_AKP = O_YS + (size_t)MS * D, O_AVP = O_AKP + (size_t)DEPTH * MP * 128,
                 O_IKP = O_AVP + (size_t)DEPTH * MP * 128, O_BKP = O_IKP + (size_t)DEPTH * MP * 64, O_BVP = O_BKP + (size_t)DEPTH * MP * 512,
                 O_AKS = O_BVP + (size_t)DEPTH * MP * 512, O_AVS = O_AKS + (size_t)DEPTH * MS * 128, O_IKS = O_AVS + (size_t)DEPTH * MS * 128,
                 O_BKS = O_IKS + (size_t)DEPTH * MS * 64, O_BVS = O_BKS + (size_t)DEPTH * MS * 512, O_END = O_BVS + (size_t)DEPTH * MS * 512;

constexpr size_t al(size_t x) { return (x + 255) & ~(size_t)255; }
constexpr size_t WS_BAR = 0;
constexpr size_t WS_ROPE = 16384;
constexpr size_t WS_WIN = WS_ROPE + al((size_t)SKEYS * 32 * 8);
constexpr size_t WS_WPA = WS_WIN + (size_t)DEPTH * NINP * D * 2;
constexpr size_t WS_WPB = WS_WPA + (size_t)DEPTH * D * 512 * 2;
constexpr size_t WS_WO  = WS_WPB + (size_t)DEPTH * D * 512 * 2;
constexpr size_t WS_WPK = WS_WO + (size_t)DEPTH * D * D * 2;
constexpr size_t WS_U16 = WS_WPK + (size_t)DEPTH * 2048 * D * 2;
constexpr size_t WS_V16 = WS_U16 + (size_t)DEPTH * NEXP * D * 2;
constexpr size_t WS_KAS = WS_V16 + (size_t)DEPTH * NEXP * D * 2;
constexpr size_t WS_VAS = WS_KAS + al((size_t)DEPTH * NB * SKEYS * 128 * 2);
constexpr size_t WS_KIS = WS_VAS + al((size_t)DEPTH * NB * SKEYS * 128 * 2);
constexpr size_t WS_H   = WS_KIS + al((size_t)DEPTH * NB * SKEYS * 64 * 2);
constexpr size_t WS_PRAW = WS_H + al((size_t)MT * D * 2);
constexpr size_t WS_QA  = WS_PRAW + al((size_t)MT * NINP * 2);
constexpr size_t WS_QI  = WS_QA + al((size_t)MT * 512 * 2);
constexpr size_t WS_QB  = WS_QI + al((size_t)MT * 512 * 2);
constexpr size_t WS_WI  = WS_QB + al((size_t)MT * 512 * 2);
constexpr size_t WS_KAP = WS_WI + al((size_t)MT * 8 * 4);
constexpr size_t WS_VAP = WS_KAP + al((size_t)MP * 128 * 2);
constexpr size_t WS_KIP = WS_VAP + al((size_t)MP * 128 * 2);
constexpr size_t WS_KBP = WS_KIP + al((size_t)MP * 64 * 2);
constexpr size_t WS_VBP = WS_KBP + al((size_t)MP * 512 * 2);
constexpr size_t WS_KBN = WS_VBP + al((size_t)MP * 512 * 2);
constexpr size_t WS_VBN = WS_KBN + al((size_t)MS * 512 * 2);
constexpr size_t WS_SGA = WS_VBN + al((size_t)MS * 512 * 2);
constexpr size_t WS_SGB = WS_SGA + al((size_t)MT * D * 2);
constexpr size_t WS_OA  = WS_SGB + al((size_t)MT * D * 2);
constexpr size_t WS_OB  = WS_OA + al((size_t)MT * 512 * 2);
constexpr size_t WS_T   = WS_OB + al((size_t)MT * 512 * 2);
constexpr size_t WS_M   = WS_T + al((size_t)MT * D * 2);
constexpr size_t WS_EID = WS_M + al((size_t)MT * D * 2);
constexpr size_t WS_GW  = WS_EID + al((size_t)MT * 128 * 4);
constexpr size_t WS_END = WS_GW + al((size_t)MT * 128 * 4);
static_assert((size_t)MT * 2048 * 4 <= (size_t)MT * NINP * 2, "scores alias");

struct Params {
    const float *x_prompt, *x_sample, *cache_a_k, *cache_a_v, *cache_idx_k, *cache_b_k, *cache_b_v;
    const float *norm1, *w_in, *qn, *kn, *ikn, *w_pa, *w_pb, *w_o, *norm2, *pwq, *pk1, *pk2, *pu, *pv;
    float* out; unsigned char* ws;
    int ph_lo, ph_hi;
};

__device__ __forceinline__ float bf2f(bf16_t v) { return __uint_as_float(((unsigned)v) << 16); }
__device__ __forceinline__ bf16_t f2bf(float f) { unsigned u = __float_as_uint(f); u += 0x7FFFu + ((u >> 16) & 1u); return (bf16_t)(u >> 16); }
__device__ __forceinline__ unsigned pk2bf(float lo, float hi) { return (unsigned)f2bf(lo) | ((unsigned)f2bf(hi) << 16); }
__device__ __forceinline__ float wsum(float v) { for (int o = 32; o; o >>= 1) v += __shfl_xor(v, o); return v; }
__device__ __forceinline__ float wmaxf(float v) { for (int o = 32; o; o >>= 1) v = fmaxf(v, __shfl_xor(v, o)); return v; }
__device__ __forceinline__ int wsumi(int v) { for (int o = 32; o; o >>= 1) v += __shfl_xor(v, o); return v; }
__device__ __forceinline__ int lane_prefix(unsigned long long m) { return (int)__builtin_amdgcn_mbcnt_hi((unsigned)(m >> 32), __builtin_amdgcn_mbcnt_lo((unsigned)m, 0u)); }
__device__ __forceinline__ float rdlane(float v, int j) { return __int_as_float(__builtin_amdgcn_readlane(__float_as_int(v), j)); }
#define WSYNC() do { asm volatile("s_waitcnt lgkmcnt(0)" ::: "memory"); __builtin_amdgcn_wave_barrier(); } while (0)
__device__ __forceinline__ unsigned fkey(float f) { const unsigned u = __float_as_uint(f); return (u & 0x80000000u) ? ~u : (u | 0x80000000u); }
__device__ __forceinline__ float softplusf(float z) { return fmaxf(z, 0.f) + log1pf(__expf(-fabsf(z))); }

#define AS4 __attribute__((address_space(4)))
typedef const AS4 Params* PP;
__device__ __forceinline__ PP kargs() { PP q = (PP)__builtin_amdgcn_kernarg_segment_ptr(); asm volatile("" : "+s"(q)); return q; }
struct Ctx { int tid, lane, wave, gwave, nwaves, bid, G; unsigned char* lds; };
__device__ __forceinline__ Ctx mkctx(unsigned char* shm) { Ctx c; int t = threadIdx.x; asm volatile("" : "+v"(t)); int b = blockIdx.x, g = gridDim.x; asm volatile("" : "+s"(b), "+s"(g));
    c.tid = t; c.lane = t & 63; c.wave = __builtin_amdgcn_readfirstlane(t >> 6); c.bid = b; c.G = g; c.gwave = b * 8 + c.wave; c.nwaves = g * 8; c.lds = shm; return c; }

__device__ __forceinline__ void transpose_tile(const Ctx& c, const float* src, int K, int N, bf16_t* dst, int k0, int n0) {
    float* t = (float*)c.lds;
    for (int i = c.tid; i < 4096; i += 512) { const int kk = i >> 6, nn = i & 63, n = n0 + nn; t[kk * 65 + nn] = (n < N) ? src[(size_t)(k0 + kk) * N + n] : 0.f; }
    __syncthreads();
    for (int i = c.tid; i < 4096; i += 512) { const int nn = i >> 6, kk = i & 63; dst[(size_t)(n0 + nn) * K + k0 + kk] = f2bf(t[kk * 65 + nn]); }
    __syncthreads();
}
__device__ __forceinline__ void phase_prologue(PP p, const Ctx& c) {
    const int G = c.G, bid = c.bid;
    {   constexpr int T_IN = (NINP / 64) * (D / 64), T_PA = (D / 64) * (512 / 64), T_O = (D / 64) * (D / 64), T_L = T_IN + 2 * T_PA + T_O;
        for (int t = bid; t < DEPTH * T_L; t += G) {
            const int l = t / T_L; int r = t % T_L;
            if (r < T_IN) { transpose_tile(c, p->w_in + (size_t)l * D * NIN, D, NIN, (bf16_t*)(p->ws + WS_WIN) + (size_t)l * NINP * D, (r % 16) * 64, (r / 16) * 64); continue; }
            r -= T_IN;
            if (r < T_PA) { transpose_tile(c, p->w_pa + (size_t)l * 512 * D, 512, D, (bf16_t*)(p->ws + WS_WPA) + (size_t)l * D * 512, (r % 8) * 64, (r / 8) * 64); continue; }
            r -= T_PA;
            if (r < T_PA) { transpose_tile(c, p->w_pb + (size_t)l * 512 * D, 512, D, (bf16_t*)(p->ws + WS_WPB) + (size_t)l * D * 512, (r % 8) * 64, (r / 8) * 64); continue; }
            r -= T_PA;
            transpose_tile(c, p->w_o + (size_t)l * D * D, D, D, (bf16_t*)(p->ws + WS_WO) + (size_t)l * D * D, (r % 16) * 64, (r / 16) * 64);
        }
    }
    {   float* Ks = (float*)c.lds; float* Ps = Ks + 128 * 65;
        for (int t = bid; t < DEPTH * 8 * 2 * 16; t += G) {
            const int kt = t & 15, j = (t >> 4) & 1, h = (t >> 5) & 7, l = t >> 8, k0 = kt * 64;
            const float* ksrc = (j ? p->pk2 : p->pk1) + ((size_t)(l * 8 + h) * 128) * 64;
            for (int i = c.tid; i < 8192; i += 512) Ks[(i >> 6) * 65 + (i & 63)] = ksrc[i];
            for (int i = c.tid; i < 4096; i += 512) Ps[(i >> 6) * 65 + (i & 63)] = p->pwq[(size_t)l * D * D + (size_t)(k0 + (i >> 6)) * D + h * 128 + j * 64 + (i & 63)];
            __syncthreads();
            const int kk = c.tid & 63, kg = c.tid >> 6;
            bf16_t* dst = (bf16_t*)(p->ws + WS_WPK) + (size_t)l * 2048 * D;
            for (int key = kg * 16; key < kg * 16 + 16; ++key) {
                float a = 0.f;
#pragma unroll 16
                for (int d = 0; d < 64; ++d) a += Ps[kk * 65 + d] * Ks[key * 65 + d];
                dst[(size_t)(h * 256 + j * 128 + key) * D + k0 + kk] = f2bf(a);
            }
            __syncthreads();
        }
    }
    const size_t gt = (size_t)bid * 512 + c.tid, gn = (size_t)G * 512;
    {   const size_t n4 = (size_t)DEPTH * NEXP * D / 4;
        const float4* su = (const float4*)p->pu; const float4* sv = (const float4*)p->pv;
        u32x2v* du = (u32x2v*)(p->ws + WS_U16); u32x2v* dv = (u32x2v*)(p->ws + WS_V16);
        for (size_t i = gt; i < n4; i += gn) { const float4 a = su[i]; u32x2v w; w.x = pk2bf(a.x, a.y); w.y = pk2bf(a.z, a.w); du[i] = w; }
        for (size_t i = gt; i < n4; i += gn) { const float4 a = sv[i]; u32x2v w; w.x = pk2bf(a.x, a.y); w.y = pk2bf(a.z, a.w); dv[i] = w; }
    }
    {   const size_t n4 = (size_t)DEPTH * NB * PAST * 128 / 4;
        const float4* sk = (const float4*)p->cache_a_k; const float4* sv = (const float4*)p->cache_a_v;
        for (size_t i = gt; i < n4; i += gn) { const size_t lb = i / (PAST * 32), rem = i % (PAST * 32); const size_t o = lb * (SKEYS * 32) + rem;
            const float4 a = sk[i]; u32x2v w; w.x = pk2bf(a.x, a.y); w.y = pk2bf(a.z, a.w); ((u32x2v*)(p->ws + WS_KAS))[o] = w;
            const float4 b = sv[i]; w.x = pk2bf(b.x, b.y); w.y = pk2bf(b.z, b.w); ((u32x2v*)(p->ws + WS_VAS))[o] = w; }
        const size_t m4 = (size_t)DEPTH * NB * PAST * 64 / 4; const float4* si = (const float4*)p->cache_idx_k;
        for (size_t i = gt; i < m4; i += gn) { const size_t lb = i / (PAST * 16), rem = i % (PAST * 16); const size_t o = lb * (SKEYS * 16) + rem;
            const float4 a = si[i]; u32x2v w; w.x = pk2bf(a.x, a.y); w.y = pk2bf(a.z, a.w); ((u32x2v*)(p->ws + WS_KIS))[o] = w; }
    }
    {   float2* rt = (float2*)(p->ws + WS_ROPE);
        for (size_t i = gt; i < (size_t)SKEYS * 32; i += gn) { const int pos = (int)(i >> 5), d = (int)(i & 31);
            const float inv = exp2f(-(float)d * (13.287712379549449f / 32.f)); const float ang = (float)pos * inv; float s, co; sincosf(ang, &s, &co); rt[i] = make_float2(co, s); }
    }
}

__device__ __forceinline__ void phase_rms(PP p, const Ctx& c, const float* gain, bool from_input) {
    bf16_t* h = (bf16_t*)(p->ws + WS_H); float* xb = p->out;
    for (int r = c.gwave; r < MT; r += c.nwaves) {
        const float* xr = from_input ? (r < MP ? p->x_prompt + (size_t)r * D : p->x_sample + (size_t)(r - MP) * D) : xb + (size_t)r * D;
        float4 v[4]; float ss = 0.f;
#pragma unroll
        for (int j = 0; j < 4; ++j) { v[j] = *(const float4*)(xr + j * 256 + c.lane * 4); ss += v[j].x * v[j].x + v[j].y * v[j].y + v[j].z * v[j].z + v[j].w * v[j].w; }
        ss = wsum(ss); const float sc = rsqrtf(ss * (1.f / D) + EPS);
#pragma unroll
        for (int j = 0; j < 4; ++j) { const float4 g = *(const float4*)(gain + j * 256 + c.lane * 4); u32x2v w; w.x = pk2bf(v[j].x * sc * g.x, v[j].y * sc * g.y); w.y = pk2bf(v[j].z * sc * g.z, v[j].w * sc * g.w);
            *(u32x2v*)(h + (size_t)r * D + j * 256 + c.lane * 4) = w;
            if (from_input) *(float4*)(xb + (size_t)r * D + j * 256 + c.lane * 4) = v[j]; }
    }
}

__device__ __forceinline__ float rope1(float y, int lane, float2 cs) { const float o = __shfl_xor(y, 32); return lane < 32 ? y * cs.x - o * cs.y : y * cs.x + o * cs.y; }
__device__ __forceinline__ void phase_post(PP p, const Ctx& c, int layer) {
    const bf16_t* praw = (const bf16_t*)(p->ws + WS_PRAW); const float2* rt = (const float2*)(p->ws + WS_ROPE);
    const int lane = c.lane;
    const float qg = p->qn[layer * 64 + lane], kg = p->kn[layer * 64 + lane], ig = p->ikn[layer * 64 + lane];
    for (int r = c.gwave; r < MT; r += c.nwaves) {
        const bool samp = r >= MP; int b, t, pos;
        if (!samp) { b = r >> 11; t = r & 2047; pos = t; } else { const int rr = r - MP; b = rr >> 4; t = rr & 15; pos = PAST + t; }
        const bf16_t* pr = praw + (size_t)r * NINP; const float2 cs = rt[pos * 32 + (lane & 31)];
        const size_t tok = samp ? (size_t)(layer * NB + b) * DSEQ + t : (size_t)(layer * NB + b) * SEQ + t;
        const size_t kpos = samp ? ((size_t)(layer * NB + b) * SKEYS + pos) : ((size_t)b * SEQ + pos);
        bf16_t* kA = (bf16_t*)(p->ws + (samp ? WS_KAS : WS_KAP)) + kpos * 128; bf16_t* vA = (bf16_t*)(p->ws + (samp ? WS_VAS : WS_VAP)) + kpos * 128;
        bf16_t* kI = (bf16_t*)(p->ws + (samp ? WS_KIS : WS_KIP)) + kpos * 64;
        float* o_ak = p->out + (samp ? O_AKS : O_AKP) + tok * 128; float* o_av = p->out + (samp ? O_AVS : O_AVP) + tok * 128; float* o_ik = p->out + (samp ? O_IKS : O_IKP) + tok * 64;
        float* o_bk = p->out + (samp ? O_BKS : O_BKP) + tok * 512; float* o_bv = p->out + (samp ? O_BVS : O_BVP) + tok * 512;
        bf16_t* kB = samp ? (bf16_t*)(p->ws + WS_KBN) + (size_t)(b * DSEQ + t) * 512 : (bf16_t*)(p->ws + WS_KBP) + ((size_t)b * SEQ + t) * 512;
        bf16_t* vB = samp ? (bf16_t*)(p->ws + WS_VBN) + (size_t)(b * DSEQ + t) * 512 : (bf16_t*)(p->ws + WS_VBP) + ((size_t)b * SEQ + t) * 512;
        bf16_t* qa = (bf16_t*)(p->ws + WS_QA) + (size_t)r * 512; bf16_t* qi = (bf16_t*)(p->ws + WS_QI) + (size_t)r * 512; bf16_t* qb = (bf16_t*)(p->ws + WS_QB) + (size_t)r * 512;
#pragma unroll
        for (int hd = 0; hd < 8; ++hd) { const float v = bf2f(pr[C_QA + hd * 64 + lane]); const float ss = wsum(v * v); const float y = v * rsqrtf(ss * (1.f / 64) + EPS) * qg; qa[hd * 64 + lane] = f2bf(rope1(y, lane, cs)); }
#pragma unroll
        for (int kv = 0; kv < 2; ++kv) { const float v = bf2f(pr[C_KA + kv * 64 + lane]); const float ss = wsum(v * v); const float y = rope1(v * rsqrtf(ss * (1.f / 64) + EPS) * kg, lane, cs);
            o_ak[kv * 64 + lane] = y; kA[kv * 64 + lane] = f2bf(y);
            const float w = bf2f(pr[C_VA + kv * 64 + lane]); o_av[kv * 64 + lane] = w; vA[kv * 64 + lane] = pr[C_VA + kv * 64 + lane]; }
#pragma unroll
        for (int hd = 0; hd < 8; ++hd) { const float v = bf2f(pr[C_QI + hd * 64 + lane]); qi[hd * 64 + lane] = f2bf(rope1(v, lane, cs)); }
        { const float v = bf2f(pr[C_KI + lane]); const float ss = wsum(v * v); const float y = rope1(v * rsqrtf(ss * (1.f / 64) + EPS) * ig, lane, cs); o_ik[lane] = y; kI[lane] = f2bf(y); }
        if (lane < 8) ((float*)(p->ws + WS_WI))[(size_t)r * 8 + lane] = bf2f(pr[C_WI + lane]) * (0.125f * 0.35355339059327373f);
#pragma unroll
        for (int j = 0; j < 8; ++j) { const int i = j * 64 + lane; qb[i] = pr[C_QB + i];
            const bf16_t k = pr[C_KB + i], v = pr[C_VB + i]; o_bk[i] = bf2f(k); kB[i] = k; o_bv[i] = bf2f(v); vB[i] = v; }
        bf16_t* sga = (bf16_t*)(p->ws + WS_SGA) + (size_t)r * D; bf16_t* sgb = (bf16_t*)(p->ws + WS_SGB) + (size_t)r * D;
#pragma unroll
        for (int j = 0; j < 16; ++j) { const int i = j * 64 + lane; const float a = bf2f(pr[C_GA + i]), g = bf2f(pr[C_GB + i]);
            sga[i] = f2bf(1.f / (1.f + __expf(-a))); sgb[i] = f2bf(1.f / (1.f + __expf(-g))); }
    }
}

constexpr int DSA_WL = 2112 + 512 + 256 + 256;
__device__ __forceinline__ void phase_dsa_naive(PP p, const Ctx& c, int layer) {
    const int lane = c.lane;
    float* wl = (float*)c.lds + (size_t)c.wave * DSA_WL; float* sc = wl; float* qf = wl + 2112; int* sel = (int*)(wl + 2112 + 512); float* pl = wl + 2112 + 512 + 256;
    for (int r = c.gwave; r < MT; r += c.nwaves) {
        const bool samp = r >= MP; int b, n; const bf16_t *kI, *kA, *vA;
        if (!samp) { b = r >> 11; const int t = r & 2047; n = ((t >> 6) + 1) << 6;
            kI = (const bf16_t*)(p->ws + WS_KIP) + (size_t)b * SEQ * 64; kA = (const bf16_t*)(p->ws + WS_KAP) + (size_t)b * SEQ * 128; vA = (const bf16_t*)(p->ws + WS_VAP) + (size_t)b * SEQ * 128; }
        else { b = (r - MP) >> 4; n = SKEYS; const size_t o = (size_t)(layer * NB + b) * SKEYS;
            kI = (const bf16_t*)(p->ws + WS_KIS) + o * 64; kA = (const bf16_t*)(p->ws + WS_KAS) + o * 128; vA = (const bf16_t*)(p->ws + WS_VAS) + o * 128; }
        WSYNC();
        { const bf16_t* q = (const bf16_t*)(p->ws + WS_QI) + (size_t)r * 512; for (int i = lane; i < 512; i += 64) qf[i] = bf2f(q[i]); }
        float w[8];
#pragma unroll
        for (int h = 0; h < 8; ++h) w[h] = ((const float*)(p->ws + WS_WI))[(size_t)r * 8 + h];
        WSYNC();
        for (int key = lane; key < n; key += 64) {
            const uint4* kr = (const uint4*)(kI + (size_t)key * 64);
            float acc[8];
#pragma unroll
            for (int h = 0; h < 8; ++h) acc[h] = 0.f;
#pragma unroll
            for (int c8 = 0; c8 < 8; ++c8) { const uint4 kv = kr[c8]; const unsigned kw[4] = {kv.x, kv.y, kv.z, kv.w};
#pragma unroll
                for (int e = 0; e < 8; ++e) { const float kf = (e & 1) ? __uint_as_float(kw[e >> 1] & 0xFFFF0000u) : __uint_as_float(kw[e >> 1] << 16);
#pragma unroll
                    for (int h = 0; h < 8; ++h) acc[h] += qf[h * 64 + c8 * 8 + e] * kf; } }
            float s = 0.f;
#pragma unroll
            for (int h = 0; h < 8; ++h) s += fmaxf(acc[h], 0.f) * w[h];
            sc[key] = s;
        }
        WSYNC();
        int nsel;
        if (n > TOPK) {
            unsigned T = 0u;
            for (int bit = 31; bit >= 0; --bit) { const unsigned cand = T | (1u << bit); int cnt = 0;
                for (int key = lane; key < n; key += 64) cnt += (fkey(sc[key]) >= cand) ? 1 : 0;
                cnt = wsumi(cnt); if (cnt >= TOPK) T = cand; }
            int cgt = 0; for (int key = lane; key < n; key += 64) cgt += (fkey(sc[key]) > T) ? 1 : 0;
            cgt = wsumi(cgt); const int need = TOPK - cgt;
            int base = 0, eqseen = 0;
            for (int k0 = 0; k0 < n; k0 += 64) { const int key = k0 + lane; const bool valid = key < n; const unsigned fk = valid ? fkey(sc[key]) : 0u;
                const bool gt = valid && fk > T, eq = valid && fk == T; const unsigned long long meq = __ballot(eq);
                const bool take = gt || (eq && (eqseen + lane_prefix(meq)) < need); const unsigned long long mt = __ballot(take);
                if (take) sel[base + lane_prefix(mt)] = key; base += __popcll(mt); eqseen += __popcll(meq); }
            nsel = TOPK;
        } else { for (int key = lane; key < n; key += 64) sel[key] = key; nsel = n; }
        WSYNC();
        const bf16_t* qa = (const bf16_t*)(p->ws + WS_QA) + (size_t)r * 512; bf16_t* oa = (bf16_t*)(p->ws + WS_OA) + (size_t)r * 512;
        for (int h = 0; h < 8; ++h) { const int kvh = h >> 2;
            WSYNC(); qf[lane] = bf2f(qa[h * 64 + lane]); WSYNC();
            float s[4]; float mx = -3.0e38f;
#pragma unroll
            for (int j = 0; j < 4; ++j) { const int idx = lane + 64 * j; s[j] = -3.0e38f;
                if (idx < nsel) { const int key = sel[idx]; const uint4* kr = (const uint4*)(kA + (size_t)key * 128 + kvh * 64); float a = 0.f;
#pragma unroll
                    for (int c8 = 0; c8 < 8; ++c8) { const uint4 kv = kr[c8]; const unsigned kw[4] = {kv.x, kv.y, kv.z, kv.w};
#pragma unroll
                        for (int e = 0; e < 8; ++e) { const float kf = (e & 1) ? __uint_as_float(kw[e >> 1] & 0xFFFF0000u) : __uint_as_float(kw[e >> 1] << 16); a += qf[c8 * 8 + e] * kf; } }
                    s[j] = a * 0.125f; mx = fmaxf(mx, s[j]); } }
            mx = wmaxf(mx); float e[4], sm = 0.f;
#pragma unroll
            for (int j = 0; j < 4; ++j) { e[j] = (lane + 64 * j < nsel) ? __expf(s[j] - mx) : 0.f; sm += e[j]; }
            sm = wsum(sm); const float inv = 1.f / sm;
#pragma unroll
            for (int j = 0; j < 4; ++j) pl[lane + 64 * j] = e[j] * inv;
            WSYNC();
            float o = 0.f;
            for (int idx = 0; idx < nsel; ++idx) { const int key = sel[idx]; o += pl[idx] * bf2f(vA[(size_t)key * 128 + kvh * 64 + lane]); }
            oa[h * 64 + lane] = f2bf(o);
        }
    }
}

__device__ __forceinline__ void phase_sb_naive(PP p, const Ctx& c, int layer) {
    const int lane = c.lane; float* qf = (float*)c.lds + c.wave * 64;
    for (int task = c.gwave; task < MT * 8; task += c.nwaves) {
        const int r = task >> 3, h = task & 7; const bool samp = r >= MP; int b, nk;
        if (!samp) { b = r >> 11; nk = r & 2047; } else { b = (r - MP) >> 4; nk = PAST + ((r - MP) & 15); }
        WSYNC(); qf[lane] = bf2f(((const bf16_t*)(p->ws + WS_QB))[(size_t)r * 512 + h * 64 + lane]); WSYNC();
        const bf16_t* kBp = (const bf16_t*)(p->ws + WS_KBP) + (size_t)b * SEQ * 512 + h * 64; const bf16_t* vBp = (const bf16_t*)(p->ws + WS_VBP) + (size_t)b * SEQ * 512 + h * 64;
        const bf16_t* kBn = (const bf16_t*)(p->ws + WS_KBN) + (size_t)b * DSEQ * 512 + h * 64; const bf16_t* vBn = (const bf16_t*)(p->ws + WS_VBN) + (size_t)b * DSEQ * 512 + h * 64;
        const float* kBc = p->cache_b_k + ((size_t)(layer * NB + b) * PAST) * 512 + h * 64; const float* vBc = p->cache_b_v + ((size_t)(layer * NB + b) * PAST) * 512 + h * 64;
        float carry = 0.f, o = 0.f;
        for (int top = nk - 1; top >= 0; top -= 64) {
            const int s = top - lane; const bool valid = s >= 0; float z = 0.f;
            if (valid) {
                if (!samp || s >= PAST) { const uint4* kr = (const uint4*)(samp ? kBn + (size_t)(s - PAST) * 512 : kBp + (size_t)s * 512);
#pragma unroll
                    for (int c8 = 0; c8 < 8; ++c8) { const uint4 kv = kr[c8]; const unsigned kw[4] = {kv.x, kv.y, kv.z, kv.w};
#pragma unroll
                        for (int e = 0; e < 8; ++e) { const float kf = (e & 1) ? __uint_as_float(kw[e >> 1] & 0xFFFF0000u) : __uint_as_float(kw[e >> 1] << 16); z += qf[c8 * 8 + e] * kf; } } }
                else { const float4* kr = (const float4*)(kBc + (size_t)s * 512);
#pragma unroll
                    for (int c4 = 0; c4 < 16; ++c4) { const float4 kv = kr[c4]; z += qf[c4 * 4] * kv.x + qf[c4 * 4 + 1] * kv.y + qf[c4 * 4 + 2] * kv.z + qf[c4 * 4 + 3] * kv.w; } }
                z *= 0.125f;
            }
            const float lr = valid ? -softplusf(z) : 0.f;
            float inc = lr;
#pragma unroll
            for (int off = 1; off < 64; off <<= 1) { const float t = __shfl_up(inc, off); if (lane >= off) inc += t; }
            const float after = carry + inc - lr;
            const float att = valid ? __expf(-softplusf(-z) + after) : 0.f;
            const int cnt = top + 1 < 64 ? top + 1 : 64;
            for (int j = 0; j < cnt; ++j) { const float a = rdlane(att, j); const int sj = top - j; float v;
                if (!samp) v = bf2f(vBp[(size_t)sj * 512 + lane]); else if (sj >= PAST) v = bf2f(vBn[(size_t)(sj - PAST) * 512 + lane]); else v = vBc[(size_t)sj * 512 + lane];
                o += a * v; }
            carry += rdlane(inc, 63);
            if (carry < -104.f) break;
        }
        ((bf16_t*)(p->ws + WS_OB))[(size_t)r * 512 + h * 64 + lane] = f2bf(o);
    }
}

__device__ __forceinline__ void phase_peer_select(PP p, const Ctx& c) {
    const int lane = c.lane; float* wl = (float*)c.lds + c.wave * 128;
    float* t1v = wl; float* t2v = wl + 16; int* t1i = (int*)(wl + 32); int* t2i = (int*)(wl + 48); float* selv = wl + 64; int* sele = (int*)(wl + 80);
    const float* scores = (const float*)(p->ws + WS_PRAW);
    for (int r = c.gwave; r < MT; r += c.nwaves) {
        for (int h = 0; h < 8; ++h) {
            const float* sr = scores + (size_t)r * 2048 + h * 256;
            WSYNC();
#pragma unroll
            for (int side = 0; side < 2; ++side) {
                const float va = sr[side * 128 + lane], vb = sr[side * 128 + 64 + lane]; int ra = 0, rb = 0;
                for (int j = 0; j < 64; ++j) { const float vj = rdlane(va, j); ra += (vj > va || (vj == va && j < lane)) ? 1 : 0; rb += (vj >= vb) ? 1 : 0; }
                for (int j = 0; j < 64; ++j) { const float vj = rdlane(vb, j); ra += (vj > va) ? 1 : 0; rb += (vj > vb || (vj == vb && j < lane)) ? 1 : 0; }
                float* tv = side ? t2v : t1v; int* ti = side ? t2i : t1i;
                if (ra < 16) { tv[ra] = va; ti[ra] = lane; }
                if (rb < 16) { tv[rb] = vb; ti[rb] = lane + 64; }
            }
            WSYNC();
            float cv[4]; int rk[4];
#pragma unroll
            for (int q = 0; q < 4; ++q) { const int cc = lane + 64 * q; cv[q] = t1v[cc >> 4] + t2v[cc & 15]; rk[q] = 0; }
            for (int j = 0; j < 256; ++j) { const float cj = t1v[j >> 4] + t2v[j & 15];
#pragma unroll
                for (int q = 0; q < 4; ++q) rk[q] += (cj > cv[q] || (cj == cv[q] && j < lane + 64 * q)) ? 1 : 0; }
#pragma unroll
            for (int q = 0; q < 4; ++q) if (rk[q] < 16) { const int cc = lane + 64 * q; selv[rk[q]] = cv[q]; sele[rk[q]] = t1i[cc >> 4] * 128 + t2i[cc & 15]; }
            WSYNC();
            const float mv = selv[0]; const float e = __expf(selv[lane & 15] - mv); float sm = e;
            sm += __shfl_xor(sm, 8); sm += __shfl_xor(sm, 4); sm += __shfl_xor(sm, 2); sm += __shfl_xor(sm, 1);
            if (lane < 16) { ((int*)(p->ws + WS_EID))[(size_t)r * 128 + h * 16 + lane] = sele[lane]; ((float*)(p->ws + WS_GW))[(size_t)r * 128 + h * 16 + lane] = e / sm; }
        }
    }
}

__device__ __forceinline__ void phase_peer_gather(PP p, const Ctx& c, int layer) {
    const int lane = c.lane; const bf16_t* U = (const bf16_t*)(p->ws + WS_U16) + (size_t)layer * NEXP * D; const bf16_t* V = (const bf16_t*)(p->ws + WS_V16) + (size_t)layer * NEXP * D;
    for (int r = c.gwave; r < MT; r += c.nwaves) {
        const bf16_t* hr = (const bf16_t*)(p->ws + WS_H) + (size_t)r * D; float xv[16], acc[16];
#pragma unroll
        for (int j = 0; j < 2; ++j) { const uint4 q = *(const uint4*)(hr + j * 512 + lane * 8); const unsigned w[4] = {q.x, q.y, q.z, q.w};
#pragma unroll
            for (int e = 0; e < 8; ++e) { xv[j * 8 + e] = (e & 1) ? __uint_as_float(w[e >> 1] & 0xFFFF0000u) : __uint_as_float(w[e >> 1] << 16); acc[j * 8 + e] = 0.f; } }
        const int* eidp = (const int*)(p->ws + WS_EID) + (size_t)r * 128; const float* gwp = (const float*)(p->ws + WS_GW) + (size_t)r * 128;
        for (int i = 0; i < 128; ++i) {
            const int e_ = __builtin_amdgcn_readfirstlane(eidp[i]); const float g = gwp[i];
            const bf16_t* ur = U + (size_t)e_ * D; float dot = 0.f;
#pragma unroll
            for (int j = 0; j < 2; ++j) { const uint4 q = *(const uint4*)(ur + j * 512 + lane * 8); const unsigned w[4] = {q.x, q.y, q.z, q.w};
#pragma unroll
                for (int e = 0; e < 8; ++e) dot += xv[j * 8 + e] * ((e & 1) ? __uint_as_float(w[e >> 1] & 0xFFFF0000u) : __uint_as_float(w[e >> 1] << 16)); }
            dot = wsum(dot);
            const float a = 0.5f * dot * (1.f + erff(dot * 0.70710678118654752f)); const float cf = g * a;
            const bf16_t* vr = V + (size_t)e_ * D;
#pragma unroll
            for (int j = 0; j < 2; ++j) { const uint4 q = *(const uint4*)(vr + j * 512 + lane * 8); const unsigned w[4] = {q.x, q.y, q.z, q.w};
#pragma unroll
                for (int e = 0; e < 8; ++e) acc[j * 8 + e] += cf * ((e & 1) ? __uint_as_float(w[e >> 1] & 0xFFFF0000u) : __uint_as_float(w[e >> 1] << 16)); }
        }
        float* xr = p->out + (size_t)r * D;
#pragma unroll
        for (int j = 0; j < 2; ++j) { float4 a0 = *(float4*)(xr + j * 512 + lane * 8), a1 = *(float4*)(xr + j * 512 + lane * 8 + 4);
            a0.x += acc[j * 8 + 0]; a0.y += acc[j * 8 + 1]; a0.z += acc[j * 8 + 2]; a0.w += acc[j * 8 + 3]; a1.x += acc[j * 8 + 4]; a1.y += acc[j * 8 + 5]; a1.z += acc[j * 8 + 6]; a1.w += acc[j * 8 + 7];
            *(float4*)(xr + j * 512 + lane * 8) = a0; *(float4*)(xr + j * 512 + lane * 8 + 4) = a1; }
    }
}

struct EPraw { bf16_t* o; __device__ __forceinline__ void store4(int row, int col, f32x4 v) const { u32x2v w; w.x = pk2bf(v[0], v[1]); w.y = pk2bf(v[2], v[3]); *(u32x2v*)(o + (size_t)row * NINP + col) = w; } };
struct EGate { bf16_t* o; const bf16_t* g; const bf16_t* add;
    __device__ __forceinline__ void store4(int row, int col, f32x4 v) const { const size_t i = (size_t)row * D + col; const u32x2v gw = *(const u32x2v*)(g + i);
        float r0 = __uint_as_float(gw.x << 16) * v[0], r1 = __uint_as_float(gw.x & 0xFFFF0000u) * v[1], r2 = __uint_as_float(gw.y << 16) * v[2], r3 = __uint_as_float(gw.y & 0xFFFF0000u) * v[3];
        if (add) { const u32x2v aw = *(const u32x2v*)(add + i); r0 += __uint_as_float(aw.x << 16); r1 += __uint_as_float(aw.x & 0xFFFF0000u); r2 += __uint_as_float(aw.y << 16); r3 += __uint_as_float(aw.y & 0xFFFF0000u); }
        u32x2v w; w.x = pk2bf(r0, r1); w.y = pk2bf(r2, r3); *(u32x2v*)(o + i) = w; } };
struct EResid { float* x; __device__ __forceinline__ void store4(int row, int col, f32x4 v) const { f32x4* q = (f32x4*)(x + (size_t)row * D + col); *q = *q + v; } };
struct EScore { float* s; __device__ __forceinline__ void store4(int row, int col, f32x4 v) const { *(f32x4*)(s + (size_t)row * 2048 + col) = v; } };

template <class F> struct EpiAdapt { static constexpr bool PERM = false, AFTER_DRAIN = false; F f;
    __device__ __forceinline__ void operator()(const f32x4 (&acc)[2][2][4][2], const pg8::Unit& u, int wr, int wc, int fr, int fq) const {
        const int row0 = u.pm * 256 + wr * 64 + fr, col0 = u.pn * 256 + wc * 32 + 4 * fq;
#pragma unroll
        for (int ai = 0; ai < 2; ++ai)
#pragma unroll
            for (int m = 0; m < 4; ++m)
#pragma unroll
                for (int bj = 0; bj < 2; ++bj)
#pragma unroll
                    for (int n = 0; n < 2; ++n) f.store4(row0 + ai * 128 + m * 16, col0 + bj * 128 + n * 16, acc[ai][bj][m][n]);
    } };

template <class F> __device__ __forceinline__ void small_gemm(const Ctx& c, const bf16_t* A, const bf16_t* Bt, int N, int K, const F& f) {
    const int ntasks = (N / 16) * 8, lane = c.lane;
    for (int task = c.gwave; task < ntasks; task += c.nwaves) {
        const int tn = task >> 3, tm = task & 7;
        const bf16_t* ap = A + (size_t)(MP + tm * 16 + (lane & 15)) * K + (lane >> 4) * 8; const bf16_t* bp = Bt + (size_t)(tn * 16 + (lane & 15)) * K + (lane >> 4) * 8;
        f32x4 acc = {0.f, 0.f, 0.f, 0.f};
#pragma unroll 4
        for (int k = 0; k < K; k += 32) { const bf16x8 a = *(const bf16x8*)(ap + k); const bf16x8 b = *(const bf16x8*)(bp + k); acc = __builtin_amdgcn_mfma_f32_16x16x32_bf16(b, a, acc, 0, 0, 0); }
        f.store4(MP + tm * 16 + (lane & 15), tn * 16 + (lane >> 4) * 4, acc);
    }
}
template <class F> __device__ __forceinline__ void gemm_both(const Ctx& c, const bf16_t* A, const bf16_t* Bt, int N, int K, const F& f) {
    pg8::Gemm g{A, Bt, MP, N, K}; pg8::StaticOrder S; S.init(MP, N, c.G, c.bid); EpiAdapt<F> E{f};
    pg8::gemm_phase<EpiAdapt<F>, pg8::StaticOrder, false>((PG8_LAS unsigned char*)c.lds, g, S, E, nullptr);
    small_gemm(c, A, Bt, N, K, f);
}

constexpr int NPH = 12;
constexpr int NSTEPS = 1 + DEPTH * NPH;
constexpr int LDS_STAGE = 131072, LDS_BYTES = LDS_STAGE + 256;

template <int layer> __device__ __forceinline__ void layer_steps(const int lo, const int hi, const XcdBarrier& bar, unsigned char* shm) {
#define KP kargs()
#ifndef PHMASK
#define PHMASK 0xFFFF
#endif
#define IN(k) (lo <= (k) && (k) < hi)
#define ON(b) ((PHMASK >> (b)) & 1)
#define SEAM(k) do { if (IN(k) && IN((k) + 1)) xcd_barrier(bar); } while (0)
        const int s0 = 1 + layer * NPH;
        if (ON(0) && IN(s0 + 0)) { phase_rms(KP, mkctx(shm), KP->norm1 + layer * D, layer == 0); }
        SEAM(s0 + 0);
        if (ON(1) && IN(s0 + 1)) { gemm_both(mkctx(shm), (const bf16_t*)(KP->ws + WS_H), (const bf16_t*)(KP->ws + WS_WIN) + (size_t)layer * NINP * D, NINP, D, EPraw{(bf16_t*)(KP->ws + WS_PRAW)}); }
        SEAM(s0 + 1);
        if (ON(2) && IN(s0 + 2)) { phase_post(KP, mkctx(shm), layer); }
        SEAM(s0 + 2);
        if (ON(3) && IN(s0 + 3)) { phase_dsa_naive(KP, mkctx(shm), layer); }
        SEAM(s0 + 3);
        if (ON(4) && IN(s0 + 4)) { phase_sb_naive(KP, mkctx(shm), layer); }
        SEAM(s0 + 4);
        if (ON(5) && IN(s0 + 5)) { gemm_both(mkctx(shm), (const bf16_t*)(KP->ws + WS_OA), (const bf16_t*)(KP->ws + WS_WPA) + (size_t)layer * D * 512, D, 512, EGate{(bf16_t*)(KP->ws + WS_T), (const bf16_t*)(KP->ws + WS_SGA), nullptr}); }
        SEAM(s0 + 5);
        if (ON(6) && IN(s0 + 6)) { gemm_both(mkctx(shm), (const bf16_t*)(KP->ws + WS_OB), (const bf16_t*)(KP->ws + WS_WPB) + (size_t)layer * D * 512, D, 512, EGate{(bf16_t*)(KP->ws + WS_M), (const bf16_t*)(KP->ws + WS_SGB), (const bf16_t*)(KP->ws + WS_T)}); }
        SEAM(s0 + 6);
        if (ON(7) && IN(s0 + 7)) { gemm_both(mkctx(shm), (const bf16_t*)(KP->ws + WS_M), (const bf16_t*)(KP->ws + WS_WO) + (size_t)layer * D * D, D, D, EResid{KP->out}); }
        SEAM(s0 + 7);
        if (ON(8) && IN(s0 + 8)) { phase_rms(KP, mkctx(shm), KP->norm2 + layer * D, false); }
        SEAM(s0 + 8);
        if (ON(9) && IN(s0 + 9)) { gemm_both(mkctx(shm), (const bf16_t*)(KP->ws + WS_H), (const bf16_t*)(KP->ws + WS_WPK) + (size_t)layer * 2048 * D, 2048, D, EScore{(float*)(KP->ws + WS_PRAW)}); }
        SEAM(s0 + 9);
        if (ON(10) && IN(s0 + 10)) { phase_peer_select(KP, mkctx(shm)); }
        SEAM(s0 + 10);
        if (ON(11) && IN(s0 + 11)) { phase_peer_gather(KP, mkctx(shm), layer); }
        SEAM(s0 + 11);
#undef KP
#undef IN
#undef ON
#undef SEAM
}

__global__ void __launch_bounds__(512, 2) k_fwd(const Params p_unused) {
    extern __shared__ __attribute__((aligned(16))) unsigned char shm[];
    volatile LAS unsigned* xbw = (volatile LAS unsigned*)(shm + LDS_STAGE);
    if (threadIdx.x < 4) xbw[threadIdx.x] = 0u;
    __syncthreads();
#define KP kargs()
    const int lo = KP->ph_lo, hi = KP->ph_hi;
    XcdBarrier bar; bar.bar = (unsigned*)(KP->ws + WS_BAR); bar.x = 0; bar.st = xbw;
    if (hi - lo > 1) bar = xcd_barrier_post((unsigned*)(KP->ws + WS_BAR), xbw);
#ifndef PHMASK
#define PHMASK 0xFFFF
#endif
#define IN(k) (lo <= (k) && (k) < hi)
#define ON(b) ((PHMASK >> (b)) & 1)
#define SEAM(k) do { if (IN(k) && IN((k) + 1)) xcd_barrier(bar); } while (0)
    if (ON(12) && IN(0)) { phase_prologue(KP, mkctx(shm)); }
    SEAM(0);
    layer_steps<0>(lo, hi, bar, shm); layer_steps<1>(lo, hi, bar, shm); layer_steps<2>(lo, hi, bar, shm); layer_steps<3>(lo, hi, bar, shm);
#undef IN
#undef KP
#undef SEAM
}
}

#ifndef MK_ONE_LAUNCH
#define MK_ONE_LAUNCH 0
#endif

extern "C" void kernel_launch(void* const* d_in, const int* in_sizes, int n_in, void* d_out, int out_size, void* d_ws, size_t ws_size, hipStream_t stream) {
    using namespace mk;
    static int grid = 0;
    if (grid == 0) {
        if (n_in != 21 || (size_t)out_size != O_END || ws_size < WS_END) { fprintf(stderr, "kernel_launch: unexpected sizes: n_in %d out %d (want %zu) ws %zu (want %zu)\n", n_in, out_size, O_END, ws_size, WS_END); grid = -1; return; }
        if (hipFuncSetAttribute((const void*)k_fwd, hipFuncAttributeMaxDynamicSharedMemorySize, LDS_BYTES) != hipSuccess) { fprintf(stderr, "kernel_launch: hipFuncSetAttribute failed\n"); grid = -1; return; }
        int dev = 0, cus = 0, per_cu = 0;
        if (hipGetDevice(&dev) != hipSuccess || hipDeviceGetAttribute(&cus, hipDeviceAttributeMultiprocessorCount, dev) != hipSuccess) { grid = -1; return; }
        if (hipOccupancyMaxActiveBlocksPerMultiprocessor(&per_cu, (const void*)k_fwd, 512, LDS_BYTES) != hipSuccess || per_cu < 1) { fprintf(stderr, "kernel_launch: occupancy query says %d\n", per_cu); (void)hipGetLastError(); }
        grid = cus;
    }
    if (grid < 0) return;
    (void)hipMemsetAsync((char*)d_ws + WS_BAR, 0, 16384, stream);
    Params p{};
    const float** pp = (const float**)&p;
    for (int i = 0; i < 21; ++i) pp[i] = (const float*)d_in[i];
    p.out = (float*)d_out; p.ws = (unsigned char*)d_ws;
#if MK_ONE_LAUNCH
    p.ph_lo = 0; p.ph_hi = NSTEPS;
    hipLaunchKernelGGL(k_fwd, dim3(grid), dim3(512), LDS_BYTES, stream, p);
#else
    for (int s = 0; s < NSTEPS; ++s) { p.ph_lo = s; p.ph_hi = s + 1; hipLaunchKernelGGL(k_fwd, dim3(grid), dim3(512), LDS_BYTES, stream, p); }
#endif
}
```

```cpp
#include <hip/hip_runtime.h>
#include <cstdio>
#include <cstdint>
namespace pg8 {
#define PG8_LAS __attribute__((address_space(3)))
typedef unsigned short bf16_t;
typedef short bf16x8 __attribute__((ext_vector_type(8)));
typedef float f32x4 __attribute__((ext_vector_type(4)));
typedef unsigned u32x4 __attribute__((ext_vector_type(4)));
constexpr int BM = 256, BK = 64, HALF = 128, HTB = HALF * BK * 2  , STAGE_BYTES = 8 * HTB, NXCD = 8, WGM = 8;

__host__ __device__ __forceinline__ int lds_byte(int r, int c) { const int st = (r >> 4) * 2 + (c >> 5), rr = r & 15, cc = c & 31, ob = rr * 64 + cc * 2; return st * 1024 + (ob ^ (((ob >> 9) & 1) << 5)); }
__host__ __device__ __forceinline__ void stage_rc(int b, int& R, int& C) { const int st = b / 1024, sb = b % 1024, swz = sb ^ (((sb >> 9) & 1) << 5); R = (st >> 1) * 16 + swz / 64; C = (st & 1) * 32 + (swz % 64) / 2; }
__host__ __device__ __forceinline__ int perm32(int rho) { const int n = rho >> 4, i = rho & 15; return 8 * (i >> 2) + 4 * n + (i & 3); }

struct Unit { int pm, pn; };
struct Gemm { const bf16_t* A; const bf16_t* Bt; int M, N, K; };

struct StaticOrder {
    int nM, nN, nwg, G, c;
    __host__ __device__ void init(int M, int N, int G_, int c_) { nM = M / BM; nN = N / BM; nwg = nM * nN; G = G_; c = c_; }
    __host__ __device__ bool next(int i, Unit& u) const {
        const long L = (long)i * G + c; if (L >= nwg) return false;
        int wgid = (int)L; { const int q = nwg / NXCD, r = nwg % NXCD, xcd = wgid % NXCD, off = wgid / NXCD; wgid = (xcd < r ? xcd * (q + 1) : r * (q + 1) + (xcd - r) * q) + off; }
        const int nig = WGM * nN, gid = wgid / nig, fm = gid * WGM, gsz = (nM - fm) < WGM ? (nM - fm) : WGM;
        u.pm = fm + ((wgid % nig) % gsz); u.pn = (wgid % nig) / gsz; return true;
    }
    __device__ __forceinline__ void a_ready(const Unit&) const {}
    __device__ __forceinline__ void done(const Unit&) const {}
};
__device__ __forceinline__ unsigned cvt_pk_bf16(float lo, float hi) { unsigned r; asm volatile("v_cvt_pk_bf16_f32 %0, %1, %2" : "=v"(r) : "v"(lo), "v"(hi)); return r; }
template <class Epi, class Sched, bool STAMP = false>
__device__ __forceinline__ void gemm_phase(PG8_LAS unsigned char* lds, const Gemm g, const Sched& S, const Epi& E, unsigned long long* stamps) {
    int tid_l = threadIdx.x; asm volatile("" : "+v"(tid_l));
    const int tid = tid_l, wid = __builtin_amdgcn_readfirstlane(tid >> 6), lane = tid & 63, wr = wid >> 2, wc = wid & 3, fr = lane & 15, fq = lane >> 4;
    const int K = g.K, nt = K / BK;
    int ts_lo = 0, ts_hi = 0, nts = 0; const unsigned long long rt_entry = STAMP ? (unsigned long long)wall_clock64() : 0ull;
#define PG8_STAMP() do { if (STAMP && wid == 0 && nts < 64) { const unsigned long long _c = (unsigned long long)clock64(); \
        ts_lo = (lane == nts) ? (int)(unsigned)_c : ts_lo; ts_hi = (lane == nts) ? (int)(unsigned)(_c >> 32) : ts_hi; ++nts; } } while (0)
    PG8_STAMP();
    unsigned voffA[2], voffB[2];
#pragma unroll
    for (int i = 0; i < 2; ++i) { int R, C; stage_rc(tid * 16 + i * 8192, R, C); const int Rb = Epi::PERM ? ((R & ~31) + perm32(R & 31)) : R;
        voffA[i] = (unsigned)(R * K + C) * 2u; voffB[i] = (unsigned)(Rb * K + C) * 2u; }
    const size_t kstep = (size_t)(BK * 2);
    const size_t hstep = (size_t)HALF * K * 2;
    const size_t tstep = 2 * hstep;
    const unsigned ldsw = (unsigned)wid * 1024u;
    const int aoff = lds_byte(wr * 64 + fr, fq * 8), boff = lds_byte(wc * 32 + fr, fq * 8);
#define PG8_SA(b, h) (((b) * 2 + (h)) * HTB)
#define PG8_SB(b, h) ((4 + (b) * 2 + (h)) * HTB)
#define PG8_STAGE(bufoff, gbase, voff) do { _Pragma("unroll") for (int _i = 0; _i < 2; ++_i) \
        __builtin_amdgcn_global_load_lds((const unsigned*)((const char*)(gbase) + (voff)[_i]), (PG8_LAS unsigned*)(lds + (bufoff) + ldsw + _i * 8192), 16, 0, 0); } while (0)
#define PG8_LDA(dst, b, h) do { _Pragma("unroll") for (int m = 0; m < 4; ++m) _Pragma("unroll") for (int k = 0; k < 2; ++k) dst[m][k] = *(const PG8_LAS bf16x8*)(lds + PG8_SA(b, h) + aoff + m * 2048 + k * 1024); } while (0)
#define PG8_LDB(dst, b, h) do { _Pragma("unroll") for (int n = 0; n < 2; ++n) _Pragma("unroll") for (int k = 0; k < 2; ++k) dst[n][k] = *(const PG8_LAS bf16x8*)(lds + PG8_SB(b, h) + boff + n * 2048 + k * 1024); } while (0)
#define PG8_MMA(ai, bj, At, Bt) do { __builtin_amdgcn_s_setprio(1); _Pragma("unroll") for (int m = 0; m < 4; ++m) _Pragma("unroll") for (int n = 0; n < 2; ++n) _Pragma("unroll") for (int k = 0; k < 2; ++k) \
        acc[ai][bj][m][n] = __builtin_amdgcn_mfma_f32_16x16x32_bf16(Bt[n][k], At[m][k], acc[ai][bj][m][n], 0, 0, 0); __builtin_amdgcn_s_setprio(0); } while (0)
#define PG8_WAIT_V(n) asm volatile("s_waitcnt vmcnt(" #n ")" ::: "memory")
#define PG8_WAIT_L(n) asm volatile("s_waitcnt lgkmcnt(" #n ")" ::: "memory")
#define PG8_BAR __builtin_amdgcn_s_barrier()
#define PG8_SCHED __builtin_amdgcn_sched_barrier(0)
    Unit cur, nxt; int ui = 0;
    if (!S.next(0, cur)) return;
    f32x4 acc[2][2][4][2];
#pragma unroll
    for (int a = 0; a < 2; ++a)
#pragma unroll
        for (int b = 0; b < 2; ++b)
#pragma unroll
            for (int m = 0; m < 4; ++m)
#pragma unroll
                for (int n = 0; n < 2; ++n) acc[a][b][m][n] = (f32x4){0.f, 0.f, 0.f, 0.f};
    bf16x8 At[4][2], B0[2][2], B1[2][2];
    const char* cA = (const char*)g.A + (size_t)cur.pm * tstep; const char* cB = (const char*)g.Bt + (size_t)cur.pn * tstep;
    S.a_ready(cur);
    PG8_STAGE(PG8_SB(0, 0), cB, voffB); PG8_STAGE(PG8_SA(0, 0), cA, voffA); PG8_STAGE(PG8_SB(0, 1), cB + hstep, voffB); PG8_STAGE(PG8_SA(0, 1), cA + hstep, voffA);
    if (wr == 1) PG8_BAR;
    PG8_WAIT_V(4); PG8_BAR;
    PG8_STAGE(PG8_SB(1, 0), cB + kstep, voffB); PG8_STAGE(PG8_SA(1, 0), cA + kstep, voffA); PG8_STAGE(PG8_SB(1, 1), cB + hstep + kstep, voffB);
    PG8_WAIT_V(6); PG8_BAR;
    PG8_STAMP();
    for (;;) {
        const bool has_next = S.next(ui + 1, nxt);
        const char* nA = has_next ? (const char*)g.A + (size_t)nxt.pm * tstep : cA; const char* nB = has_next ? (const char*)g.Bt + (size_t)nxt.pn * tstep : cB;
        for (int t = 0; t < nt; t += 2) {
            const bool last = (t == nt - 2);
            const char* a1 = cA + (size_t)(t + 1) * kstep;
            const char* a2 = last ? nA : cA + (size_t)(t + 2) * kstep; const char* b2 = last ? nB : cB + (size_t)(t + 2) * kstep;
            const char* a3 = a2 + kstep; const char* b3 = b2 + kstep;
            if (last && has_next) S.a_ready(nxt);
            PG8_LDB(B0, 0, 0); PG8_SCHED; PG8_LDA(At, 0, 0); PG8_STAGE(PG8_SA(1, 1), a1 + hstep, voffA);
            PG8_WAIT_L(8); PG8_BAR; PG8_WAIT_L(0); PG8_MMA(0, 0, At, B0); PG8_BAR; PG8_SCHED;
            PG8_LDB(B1, 0, 1); PG8_STAGE(PG8_SB(0, 0), b2, voffB);
            PG8_BAR; PG8_WAIT_L(0); PG8_MMA(0, 1, At, B1); PG8_BAR;
            PG8_LDA(At, 0, 1); PG8_STAGE(PG8_SA(0, 0), a2, voffA);
            PG8_BAR; PG8_WAIT_L(0); PG8_MMA(1, 0, At, B0); PG8_BAR; PG8_SCHED;
            PG8_STAGE(PG8_SB(0, 1), b2 + hstep, voffB);
            PG8_WAIT_V(6); PG8_BAR; PG8_MMA(1, 1, At, B1); PG8_BAR;
            PG8_LDB(B0, 1, 0); PG8_SCHED; PG8_LDA(At, 1, 0); PG8_STAGE(PG8_SA(0, 1), a2 + hstep, voffA);
            PG8_WAIT_L(8); PG8_BAR; PG8_WAIT_L(0); PG8_MMA(0, 0, At, B0); PG8_BAR; PG8_SCHED;
            PG8_LDB(B1, 1, 1); PG8_STAGE(PG8_SB(1, 0), b3, voffB);
            PG8_BAR; PG8_WAIT_L(0); PG8_MMA(0, 1, At, B1); PG8_BAR;
            PG8_LDA(At, 1, 1); PG8_STAGE(PG8_SA(1, 0), a3, voffA);
            PG8_BAR; PG8_WAIT_L(0); PG8_MMA(1, 0, At, B0); PG8_BAR; PG8_SCHED;
            PG8_STAGE(PG8_SB(1, 1), b3 + hstep, voffB);
            PG8_WAIT_V(6); PG8_BAR; PG8_MMA(1, 1, At, B1); PG8_BAR;
        }
        PG8_STAMP();
        if constexpr (!Epi::AFTER_DRAIN) { E(acc, cur, wr, wc, fr, fq); S.done(cur); }
        PG8_STAMP();
        if (!has_next) break;
#pragma unroll
        for (int a = 0; a < 2; ++a)
#pragma unroll
            for (int b = 0; b < 2; ++b)
#pragma unroll
                for (int m = 0; m < 4; ++m)
#pragma unroll
                    for (int n = 0; n < 2; ++n) acc[a][b][m][n] = (f32x4){0.f, 0.f, 0.f, 0.f};
        cur = nxt; cA = nA; cB = nB; ++ui;
    }
    PG8_WAIT_V(0);
    if (wr == 0) PG8_BAR;
    PG8_BAR;
    if constexpr (Epi::AFTER_DRAIN) { E.fused(acc, cur, wr, wc, fr, fq, lds, wid, lane); S.done(cur); }
    PG8_STAMP();
    if (STAMP && wid == 0) { stamps[lane] = lane < nts ? (((unsigned long long)(unsigned)ts_hi << 32) | (unsigned)ts_lo) : 0ull;
        if (lane == 62) stamps[62] = rt_entry; if (lane == 63) stamps[63] = (unsigned long long)wall_clock64(); }
#undef PG8_STAMP
#undef PG8_SA
#undef PG8_SB
#undef PG8_STAGE
#undef PG8_LDA
#undef PG8_LDB
#undef PG8_MMA
#undef PG8_WAIT_V
#undef PG8_WAIT_L
#undef PG8_BAR
#undef PG8_SCHED
}
}
#define XB_TMO      128
#define XB_XCNT(j)  (256  + 64 * (j))
#define XB_XSUB(j)  (1280 + 64 * (j))
#define XB_XGEN(j)  (2304 + 64 * (j))
#define XB_TOP      3328
#define XB_TOPGEN   3392
#define XCD_BAR_WORDS 3456
#define XB_SPIN_CAP (1u << 18)
#define LAS __attribute__((address_space(3)))

__device__ __forceinline__ unsigned xb_ld(unsigned* p)              { return __hip_atomic_load(p, __ATOMIC_RELAXED, __HIP_MEMORY_SCOPE_AGENT); }
__device__ __forceinline__ unsigned xb_add(unsigned* p, unsigned v) { return __hip_atomic_fetch_add(p, v, __ATOMIC_RELAXED, __HIP_MEMORY_SCOPE_AGENT); }
__device__ __forceinline__ unsigned xb_xcc_id() { return (unsigned)__builtin_amdgcn_s_getreg((3 << 11) | 20) & 0xFu; }
#define XB_SPIN(cond, bar) do { unsigned _sp = 0; while (cond) { __builtin_amdgcn_s_sleep(1); \
    if ((++_sp & 255u) == 0u) { if (xb_ld(&(bar)[XB_TMO])) break; if (_sp > XB_SPIN_CAP) { atomicAdd(&(bar)[XB_TMO], 1u); break; } } } } while (0)

struct XcdBarrier {
    unsigned* bar; unsigned x;
    volatile LAS unsigned* st;
};

__device__ __forceinline__ XcdBarrier xcd_barrier_post(unsigned* bar, volatile LAS unsigned* st) {
    XcdBarrier b; b.bar = bar; b.x = xb_xcc_id(); b.st = st;
    if (threadIdx.x == 0) (void)xb_add(&bar[XB_XCNT(b.x)], 1u);
    return b;
}
__device__ __forceinline__ void xcd_barrier_complete(unsigned* bar, unsigned x, unsigned& nloc, unsigned& nx) {
    const unsigned G = gridDim.x * gridDim.y * gridDim.z;
    unsigned sum, cnt, mine, sp = 0u;
    for (;;) {
        sum = 0u; cnt = 0u; mine = 0u;
#pragma unroll
        for (unsigned j = 0; j < 16; ++j) { const unsigned c = xb_ld(&bar[XB_XCNT(j)]); sum += c; cnt += (c > 0u) ? 1u : 0u; mine = (j == x) ? c : mine; }
        if (sum == G) break;
        __builtin_amdgcn_s_sleep(1);
        if ((++sp & 255u) == 0u) { if (xb_ld(&bar[XB_TMO])) break; if (sp > XB_SPIN_CAP) { atomicAdd(&bar[XB_TMO], 1u); break; } }
    }
    nloc = mine > 0u ? mine : 1u; nx = cnt > 0u ? cnt : 1u;
}

__device__ __forceinline__ void xcd_barrier(const XcdBarrier& b) {
    asm volatile("s_waitcnt vmcnt(0)" ::: "memory");
    __syncthreads();
    if (threadIdx.x == 0) {
        unsigned* bar = b.bar;
        __builtin_amdgcn_s_waitcnt(0);
        unsigned nloc = b.st[0], nx = b.st[1];
        if (nloc == 0u) { xcd_barrier_complete(bar, b.x, nloc, nx); b.st[0] = nloc; b.st[1] = nx; }
        const unsigned old = xb_add(&bar[XB_XSUB(b.x)], 1u);
        const unsigned gen = old / nloc;
        if (old + 1u == (gen + 1u) * nloc) {
            __builtin_amdgcn_fence(__ATOMIC_RELEASE, "agent");
            asm volatile("s_waitcnt vmcnt(0)" ::: "memory");
            const unsigned og = xb_add(&bar[XB_TOP], 1u);
            const unsigned tg = og / nx;
            if (og + 1u == (tg + 1u) * nx) xb_add(&bar[XB_TOPGEN], 1u);
            else XB_SPIN(xb_ld(&bar[XB_TOPGEN]) == tg, bar);
            __builtin_amdgcn_fence(__ATOMIC_ACQUIRE, "agent");
            xb_add(&bar[XB_XGEN(b.x)], 1u);
            asm volatile("s_waitcnt vmcnt(0)" ::: "memory");
        } else {
            XB_SPIN(xb_ld(&bar[XB_XGEN(b.x)]) == gen, bar);
            __builtin_amdgcn_fence(__ATOMIC_ACQUIRE, "agent");
            asm volatile("s_waitcnt vmcnt(0)" ::: "memory");
        }
    }
    __syncthreads();
}

namespace mk {
using pg8::bf16_t; using pg8::bf16x8; using pg8::f32x4;
typedef unsigned u32x2v __attribute__((ext_vector_type(2)));
typedef float f32x16 __attribute__((ext_vector_type(16)));
typedef __bf16 bf16x2_t __attribute__((ext_vector_type(2)));
typedef float f32x2v __attribute__((ext_vector_type(2)));
typedef unsigned u32x4v __attribute__((ext_vector_type(4)));

constexpr int D = 1024, NB = 8, SEQ = 2048, DEPTH = 4, DSEQ = 16, PAST = 2048, SKEYS = PAST + DSEQ;
constexpr int MP = NB * SEQ, MS = NB * DSEQ, MT = MP + MS;
constexpr int NIN = 4936, NINP = 5120;
constexpr int C_QA = 0, C_KA = 512, C_VA = 640, C_QI = 768, C_KI = 1280, C_WI = 1344, C_QB = 1352, C_KB = 1864, C_VB = 2376, C_GA = 2888, C_GB = 3912;
constexpr int NEXP = 16384, TOPK = 256;
constexpr float EPS = 1e-6f;

constexpr size_t O_YP = 0, O_YS = O_YP + (size_t)MP * D, O_AKP = O_YS + (size_t)MS * D, O_AVP = O_AKP + (size_t)DEPTH * MP * 128,
                 O_IKP = O_AVP + (size_t)DEPTH * MP * 128, O_BKP = O_IKP + (size_t)DEPTH * MP * 64, O_BVP = O_BKP + (size_t)DEPTH * MP * 512,
                 O_AKS = O_BVP + (size_t)DEPTH * MP * 512, O_AVS = O_AKS + (size_t)DEPTH * MS * 128, O_IKS = O_AVS + (size_t)DEPTH * MS * 128,
                 O_BKS = O_IKS + (size_t)DEPTH * MS * 64, O_BVS = O_BKS + (size_t)DEPTH * MS * 512, O_END = O_BVS + (size_t)DEPTH * MS * 512;

constexpr size_t al(size_t x) { return (x + 255) & ~(size_t)255; }
constexpr size_t WS_BAR = 0;
constexpr size_t WS_CTR = 16384;
constexpr int CTR_PER_LAYER = 128;
constexpr size_t WS_ZERO_BYTES = 16384 + (size_t)DEPTH * CTR_PER_LAYER * 256;
constexpr size_t WS_ROPE = 163840;
constexpr size_t WS_WIN = WS_ROPE + al((size_t)SKEYS * 32 * 8);
constexpr size_t WS_WPA = WS_WIN + (size_t)DEPTH * NINP * D * 2;
constexpr size_t WS_WPB = WS_WPA + (size_t)DEPTH * D * 512 * 2;
constexpr size_t WS_WO  = WS_WPB + (size_t)DEPTH * D * 512 * 2;
constexpr size_t WS_WPK = WS_WO + (size_t)DEPTH * D * D * 2;
constexpr size_t WS_U8  = WS_WPK + (size_t)DEPTH * 2048 * D * 2;
constexpr size_t WS_V8  = WS_U8 + (size_t)DEPTH * NEXP * D;
constexpr size_t WS_SUI = WS_V8 + (size_t)DEPTH * NEXP * D;
constexpr size_t WS_SVI = WS_SUI + (size_t)DEPTH * NEXP * 4;
constexpr size_t WS_X8  = WS_SVI + (size_t)DEPTH * NEXP * 4;
constexpr size_t WS_KAS = WS_X8 + al((size_t)MT * D);
constexpr size_t WS_VAS = WS_KAS + al((size_t)DEPTH * NB * SKEYS * 128 * 2);
constexpr size_t WS_KIS = WS_VAS + al((size_t)DEPTH * NB * SKEYS * 128 * 2);
constexpr size_t WS_H   = WS_KIS + al((size_t)DEPTH * NB * SKEYS * 64 * 2);
constexpr size_t WS_PRAW = WS_H + al((size_t)MT * D * 2);
constexpr size_t WS_QA  = WS_PRAW + al((size_t)MT * NINP * 2);
constexpr size_t WS_QI  = WS_QA + al((size_t)MT * 512 * 2);
constexpr size_t WS_QB  = WS_QI + al((size_t)MT * 512 * 2);
constexpr size_t WS_WI  = WS_QB + al((size_t)MT * 512 * 2);
constexpr size_t WS_KAP = WS_WI + al((size_t)MT * 8 * 4);
constexpr size_t WS_VAP = WS_KAP + al((size_t)MP * 128 * 2);
constexpr size_t WS_KIP = WS_VAP + al((size_t)MP * 128 * 2);
constexpr size_t WS_KBP = WS_KIP + al((size_t)MP * 64 * 2);
constexpr size_t WS_VBP = WS_KBP + al((size_t)MP * 512 * 2);
constexpr size_t WS_KBN = WS_VBP + al((size_t)MP * 512 * 2);
constexpr size_t WS_VBN = WS_KBN + al((size_t)MS * 512 * 2);
constexpr size_t WS_SGA = WS_VBN + al((size_t)MS * 512 * 2);
constexpr size_t WS_SGB = WS_SGA + al((size_t)MT * D * 2);
constexpr size_t WS_OA  = WS_SGB + al((size_t)MT * D * 2);
constexpr size_t WS_OB  = WS_OA + al((size_t)MT * 512 * 2);
constexpr size_t WS_T   = WS_OB + al((size_t)MT * 512 * 2);
constexpr size_t WS_M   = WS_T + al((size_t)MT * D * 2);
constexpr size_t WS_EID = WS_M + al((size_t)MT * D * 2);
constexpr size_t WS_GW  = WS_EID + al((size_t)MT * 128 * 4);
constexpr size_t WS_VBT = WS_GW + al((size_t)MT * 128 * 4);
constexpr size_t WS_VAT = WS_VBT + al((size_t)NB * 8 * 64 * SEQ * 2);
constexpr int SKP = 2080;
constexpr size_t WS_VATS = WS_VAT + al((size_t)NB * 2 * 64 * SEQ * 2);
constexpr size_t WS_MASK = WS_VATS + al((size_t)DEPTH * NB * 2 * 64 * SKP * 2);
constexpr int SBT = 240, SBL = SBT + DSEQ;
constexpr size_t WS_KBS = WS_MASK + al((size_t)65 * MT * 4);
constexpr size_t WS_VBTS = WS_KBS + (size_t)DEPTH * NB * SBL * 512 * 2;
constexpr size_t WS_SCR = WS_VBTS + (size_t)DEPTH * NB * 8 * 64 * SBL * 2;
constexpr size_t WS_END = WS_SCR + (size_t)2 * 256 * 128 * 256 * 4;
static_assert((size_t)MT * 2048 * 4 <= (size_t)MT * NINP * 2, "scores alias");

struct Params {
    const float *x_prompt, *x_sample, *cache_a_k, *cache_a_v, *cache_idx_k, *cache_b_k, *cache_b_v;
    const float *norm1, *w_in, *qn, *kn, *ikn, *w_pa, *w_pb, *w_o, *norm2, *pwq, *pk1, *pk2, *pu, *pv;
    float* out; unsigned char* ws;
    int ph_lo, ph_hi;
};

__device__ __forceinline__ float bf2f(bf16_t v) { return __uint_as_float(((unsigned)v) << 16); }
__device__ __forceinline__ bf16_t f2bf(float f) { unsigned u = __float_as_uint(f); u += 0x7FFFu + ((u >> 16) & 1u); return (bf16_t)(u >> 16); }
__device__ __forceinline__ unsigned pk2bf(float lo, float hi) { return (unsigned)f2bf(lo) | ((unsigned)f2bf(hi) << 16); }
__device__ __forceinline__ float wsum(float v) { for (int o = 32; o; o >>= 1) v += __shfl_xor(v, o); return v; }
__device__ __forceinline__ float wmaxf(float v) { for (int o = 32; o; o >>= 1) v = fmaxf(v, __shfl_xor(v, o)); return v; }
__device__ __forceinline__ int wsumi(int v) { for (int o = 32; o; o >>= 1) v += __shfl_xor(v, o); return v; }
__device__ __forceinline__ int lane_prefix(unsigned long long m) { return (int)__builtin_amdgcn_mbcnt_hi((unsigned)(m >> 32), __builtin_amdgcn_mbcnt_lo((unsigned)m, 0u)); }
__device__ __forceinline__ float rdlane(float v, int j) { return __int_as_float(__builtin_amdgcn_readlane(__float_as_int(v), j)); }
#define WSYNC() do { asm volatile("s_waitcnt lgkmcnt(0)" ::: "memory"); __builtin_amdgcn_wave_barrier(); } while (0)
__device__ __forceinline__ unsigned fkey(float f) { const unsigned u = __float_as_uint(f); return (u & 0x80000000u) ? ~u : (u | 0x80000000u); }
__device__ __forceinline__ float softplusf(float z) { return fmaxf(z, 0.f) + log1pf(__expf(-fabsf(z))); }

#define AS4 __attribute__((address_space(4)))
typedef const AS4 Params* PP;
__device__ __forceinline__ PP kargs() { PP q = (PP)__builtin_amdgcn_kernarg_segment_ptr(); asm volatile("" : "+s"(q)); return q; }
#define UNPK8(q, f) do { const unsigned w_[4] = {(q).x, (q).y, (q).z, (q).w}; _Pragma("unroll") for (int e_ = 0; e_ < 8; ++e_) (f)[e_] = (e_ & 1) ? __uint_as_float(w_[e_ >> 1] & 0xFFFF0000u) : __uint_as_float(w_[e_ >> 1] << 16); } while (0)
struct Ctx { int tid, lane, wave, gwave, nwaves, bid, G; unsigned char* lds; };
__device__ __forceinline__ Ctx mkctx(unsigned char* shm) { Ctx c; int t = threadIdx.x; asm volatile("" : "+v"(t)); int b = blockIdx.x, g = gridDim.x; asm volatile("" : "+s"(b), "+s"(g));
    c.tid = t; c.lane = t & 63; c.wave = __builtin_amdgcn_readfirstlane(t >> 6); c.bid = b; c.G = g; c.gwave = b * 8 + c.wave; c.nwaves = g * 8; c.lds = shm; return c; }

__device__ __forceinline__ void transpose_tile(const Ctx& c, const float* src, int K, int N, bf16_t* dst, int k0, int n0) {
    float* t = (float*)c.lds;
    for (int i = c.tid; i < 4096; i += 512) { const int kk = i >> 6, nn = i & 63, n = n0 + nn; t[kk * 65 + nn] = (n < N) ? src[(size_t)(k0 + kk) * N + n] : 0.f; }
    __syncthreads();
    for (int i = c.tid; i < 4096; i += 512) { const int nn = i >> 6, kk = i & 63; dst[(size_t)(n0 + nn) * K + k0 + kk] = f2bf(t[kk * 65 + nn]); }
    __syncthreads();
}
__device__ __forceinline__ void phase_prologue(PP p, const Ctx& c) {
    const int G = c.G, bid = c.bid;
    {   constexpr int T_IN = (NINP / 64) * (D / 64), T_PA = (D / 64) * (512 / 64), T_O = (D / 64) * (D / 64), T_L = T_IN + 2 * T_PA + T_O;
        for (int t = bid; t < DEPTH * T_L; t += G) {
            const int l = t / T_L; int r = t % T_L;
            if (r < T_IN) { transpose_tile(c, p->w_in + (size_t)l * D * NIN, D, NIN, (bf16_t*)(p->ws + WS_WIN) + (size_t)l * NINP * D, (r % 16) * 64, (r / 16) * 64); continue; }
            r -= T_IN;
            if (r < T_PA) { transpose_tile(c, p->w_pa + (size_t)l * 512 * D, 512, D, (bf16_t*)(p->ws + WS_WPA) + (size_t)l * D * 512, (r % 8) * 64, (r / 8) * 64); continue; }
            r -= T_PA;
            if (r < T_PA) { transpose_tile(c, p->w_pb + (size_t)l * 512 * D, 512, D, (bf16_t*)(p->ws + WS_WPB) + (size_t)l * D * 512, (r % 8) * 64, (r / 8) * 64); continue; }
            r -= T_PA;
            transpose_tile(c, p->w_o + (size_t)l * D * D, D, D, (bf16_t*)(p->ws + WS_WO) + (size_t)l * D * D, (r % 16) * 64, (r / 16) * 64);
        }
    }
    {   float* Ks = (float*)c.lds; float* Ps = Ks + 128 * 65;
        for (int t = bid; t < DEPTH * 8 * 2 * 16; t += G) {
            const int kt = t & 15, j = (t >> 4) & 1, h = (t >> 5) & 7, l = t >> 8, k0 = kt * 64;
            const float* ksrc = (j ? p->pk2 : p->pk1) + ((size_t)(l * 8 + h) * 128) * 64;
            for (int i = c.tid; i < 8192; i += 512) Ks[(i >> 6) * 65 + (i & 63)] = ksrc[i];
            for (int i = c.tid; i < 4096; i += 512) Ps[(i >> 6) * 65 + (i & 63)] = p->pwq[(size_t)l * D * D + (size_t)(k0 + (i >> 6)) * D + h * 128 + j * 64 + (i & 63)];
            __syncthreads();
            const int kk = c.tid & 63, kg = c.tid >> 6;
            bf16_t* dst = (bf16_t*)(p->ws + WS_WPK) + (size_t)l * 2048 * D;
            for (int key = kg * 16; key < kg * 16 + 16; ++key) {
                float a = 0.f;
#pragma unroll 16
                for (int d = 0; d < 64; ++d) a += Ps[kk * 65 + d] * Ks[key * 65 + d];
                dst[(size_t)(h * 256 + j * 128 + key) * D + k0 + kk] = f2bf(a);
            }
            __syncthreads();
        }
    }
    const size_t gt = (size_t)bid * 512 + c.tid, gn = (size_t)G * 512;
    for (int task = c.gwave; task < 2 * DEPTH * NEXP; task += c.nwaves) {
        const int isv = task & 1, le = task >> 1, l = le >> 14, e = le & 16383; const int lane = c.lane;
        const float* src = (isv ? p->pv : p->pu) + (size_t)le * D + lane * 16; float f[16];
#pragma unroll
        for (int j = 0; j < 4; ++j) { const float4 q = *(const float4*)(src + 4 * j); f[4 * j] = q.x; f[4 * j + 1] = q.y; f[4 * j + 2] = q.z; f[4 * j + 3] = q.w; }
        float mx = 0.f;
#pragma unroll
        for (int j = 0; j < 16; ++j) mx = fmaxf(mx, fabsf(f[j]));
        mx = wmaxf(mx); const float sc = mx > 0.f ? 224.f / mx : 1.f;
        unsigned w[4];
#pragma unroll
        for (int j = 0; j < 4; ++j) { int pk = __builtin_amdgcn_cvt_pk_fp8_f32(f[4 * j] * sc, f[4 * j + 1] * sc, 0, false); pk = __builtin_amdgcn_cvt_pk_fp8_f32(f[4 * j + 2] * sc, f[4 * j + 3] * sc, pk, true); w[j] = (unsigned)pk; }
        if (!isv) *(uint4*)(p->ws + WS_U8 + (size_t)le * D + lane * 16) = make_uint4(w[0], w[1], w[2], w[3]);
        else *(uint4*)(p->ws + WS_V8 + (((size_t)l * 8 + (lane >> 3)) * NEXP + e) * 128 + (lane & 7) * 16) = make_uint4(w[0], w[1], w[2], w[3]);
        if (lane == 0) ((float*)(p->ws + (isv ? WS_SVI : WS_SUI)))[le] = 1.f / sc;
    }
    {   const size_t n4 = (size_t)DEPTH * NB * PAST * 128 / 4;
        const float4* sk = (const float4*)p->cache_a_k; const float4* sv = (const float4*)p->cache_a_v;
        for (size_t i = gt; i < n4; i += gn) { const size_t lb = i / (PAST * 32), rem = i % (PAST * 32); const size_t o = lb * (SKEYS * 32) + rem;
            const float4 a = sk[i]; u32x2v w; w.x = pk2bf(a.x, a.y); w.y = pk2bf(a.z, a.w); ((u32x2v*)(p->ws + WS_KAS))[o] = w;
            const float4 b = sv[i]; w.x = pk2bf(b.x, b.y); w.y = pk2bf(b.z, b.w); ((u32x2v*)(p->ws + WS_VAS))[o] = w; }
        const size_t m4 = (size_t)DEPTH * NB * PAST * 64 / 4; const float4* si = (const float4*)p->cache_idx_k;
        for (size_t i = gt; i < m4; i += gn) { const size_t lb = i / (PAST * 16), rem = i % (PAST * 16); const size_t o = lb * (SKEYS * 16) + rem;
            const float4 a = si[i]; u32x2v w; w.x = pk2bf(a.x, a.y); w.y = pk2bf(a.z, a.w); ((u32x2v*)(p->ws + WS_KIS))[o] = w; }
    }
    for (int task = c.gwave; task < DEPTH * NB * 128 * 2; task += c.nwaves) {
        const int kvh = task & 1, grp = (task >> 1) & 127, lb = task >> 8;
        const float* src = p->cache_a_v + ((size_t)lb * PAST + grp * 16) * 128 + kvh * 64 + c.lane;
        unsigned v[16];
#pragma unroll
        for (int i = 0; i < 16; ++i) v[i] = f2bf(src[(size_t)i * 128]);
        unsigned w[8];
#pragma unroll
        for (int i = 0; i < 8; ++i) { const int s0 = 2 * i, s1 = 2 * i + 1;
            const int o0 = 8 * ((s0 >> 2) & 1) + 4 * (s0 >> 3) + (s0 & 3), o1 = 8 * ((s1 >> 2) & 1) + 4 * (s1 >> 3) + (s1 & 3); w[i] = v[o0] | (v[o1] << 16); }
        bf16_t* dst = (bf16_t*)(p->ws + WS_VATS) + ((size_t)(lb * 2 + kvh) * 64 + c.lane) * SKP + grp * 16;
        *(uint4*)dst = make_uint4(w[0], w[1], w[2], w[3]); *(uint4*)(dst + 8) = make_uint4(w[4], w[5], w[6], w[7]);
    }
    for (size_t i = gt; i < (size_t)DEPTH * NB * SBT * 128; i += gn) { const size_t lb = i / (SBT * 128), rem = i % (SBT * 128);
        const float4 a = ((const float4*)p->cache_b_k)[(lb * PAST + (PAST - SBT)) * 128 + rem]; u32x2v w; w.x = pk2bf(a.x, a.y); w.y = pk2bf(a.z, a.w); ((u32x2v*)(p->ws + WS_KBS))[lb * (SBL * 128) + rem] = w; }
    for (int task = c.gwave; task < DEPTH * NB * 8 * (SBT / 16); task += c.nwaves) {
        const int grp = task % (SBT / 16), h = (task / (SBT / 16)) & 7, lb = task / ((SBT / 16) * 8);
        const float* src = p->cache_b_v + ((size_t)lb * PAST + (PAST - SBT) + grp * 16) * 512 + h * 64 + c.lane;
        unsigned v[16];
#pragma unroll
        for (int i = 0; i < 16; ++i) v[i] = f2bf(src[(size_t)i * 512]);
        unsigned w[8];
#pragma unroll
        for (int i = 0; i < 8; ++i) { const int s0 = 2 * i, s1 = 2 * i + 1;
            const int o0 = 8 * ((s0 >> 2) & 1) + 4 * (s0 >> 3) + (s0 & 3), o1 = 8 * ((s1 >> 2) & 1) + 4 * (s1 >> 3) + (s1 & 3); w[i] = v[o0] | (v[o1] << 16); }
        bf16_t* dst = (bf16_t*)(p->ws + WS_VBTS) + ((size_t)(lb * 8 + h) * 64 + c.lane) * SBL + grp * 16;
        *(uint4*)dst = make_uint4(w[0], w[1], w[2], w[3]); *(uint4*)(dst + 8) = make_uint4(w[4], w[5], w[6], w[7]);
    }
    {   float2* rt = (float2*)(p->ws + WS_ROPE);
        for (size_t i = gt; i < (size_t)SKEYS * 32; i += gn) { const int pos = (int)(i >> 5), d = (int)(i & 31);
            const float inv = exp2f(-(float)d * (13.287712379549449f / 32.f)); const float ang = (float)pos * inv; float s, co; sincosf(ang, &s, &co); rt[i] = make_float2(co, s); }
    }
}

__device__ __forceinline__ void phase_rms(PP p, const Ctx& c, const float* gain, bool from_input) {
    bf16_t* h = (bf16_t*)(p->ws + WS_H); float* xb = p->out;
    float4 g[4];
#pragma unroll
    for (int j = 0; j < 4; ++j) g[j] = *(const float4*)(gain + j * 256 + c.lane * 4);
#define RMS_SRC(r_) (from_input ? ((r_) < MP ? p->x_prompt + (size_t)(r_) * D : p->x_sample + (size_t)((r_) - MP) * D) : xb + (size_t)(r_) * D)
    float4 vn[4], vm[4];
    { const int r0 = c.gwave < MT ? c.gwave : MT - 1; const float* xr = RMS_SRC(r0);
#pragma unroll
      for (int j = 0; j < 4; ++j) vn[j] = *(const float4*)(xr + j * 256 + c.lane * 4); }
    { const int r1 = c.gwave + c.nwaves < MT ? c.gwave + c.nwaves : MT - 1; const float* xr = RMS_SRC(r1);
#pragma unroll
      for (int j = 0; j < 4; ++j) vm[j] = *(const float4*)(xr + j * 256 + c.lane * 4); }
    for (int r = c.gwave; r < MT; r += c.nwaves) {
        float4 v[4];
#pragma unroll
        for (int j = 0; j < 4; ++j) { v[j] = vn[j]; vn[j] = vm[j]; }
        { const int rn = r + 2 * c.nwaves < MT ? r + 2 * c.nwaves : MT - 1; const float* xr = RMS_SRC(rn);
#pragma unroll
          for (int j = 0; j < 4; ++j) vm[j] = *(const float4*)(xr + j * 256 + c.lane * 4); }
        float ss = 0.f;
#pragma unroll
        for (int j = 0; j < 4; ++j) ss += v[j].x * v[j].x + v[j].y * v[j].y + v[j].z * v[j].z + v[j].w * v[j].w;
        ss = wsum(ss); const float sc = rsqrtf(ss * (1.f / D) + EPS);
#pragma unroll
        for (int j = 0; j < 4; ++j) { u32x2v w; w.x = pk2bf(v[j].x * sc * g[j].x, v[j].y * sc * g[j].y); w.y = pk2bf(v[j].z * sc * g[j].z, v[j].w * sc * g[j].w);
            *(u32x2v*)(h + (size_t)r * D + j * 256 + c.lane * 4) = w;
            { int pk = __builtin_amdgcn_cvt_pk_fp8_f32(v[j].x * sc * g[j].x, v[j].y * sc * g[j].y, 0, false); pk = __builtin_amdgcn_cvt_pk_fp8_f32(v[j].z * sc * g[j].z, v[j].w * sc * g[j].w, pk, true); *(int*)(p->ws + WS_X8 + (size_t)r * D + j * 256 + c.lane * 4) = pk; }
            if (from_input) *(float4*)(xb + (size_t)r * D + j * 256 + c.lane * 4) = v[j]; }
    }
#undef RMS_SRC
}

__device__ __forceinline__ float rope1(float y, int lane, float2 cs) { const float o = __shfl_xor(y, 32); return lane < 32 ? y * cs.x - o * cs.y : y * cs.x + o * cs.y; }
__device__ __forceinline__ void phase_post(PP p, const Ctx& c, int layer) {
    const bf16_t* praw = (const bf16_t*)(p->ws + WS_PRAW); const float2* rt = (const float2*)(p->ws + WS_ROPE);
    const int lane = c.lane, j8 = (lane & 7) * 8; const bool lowhalf = (lane & 4) == 0;
    float qg[8], kg[8], ig[8];
#pragma unroll
    for (int e = 0; e < 8; ++e) { qg[e] = p->qn[layer * 64 + j8 + e]; kg[e] = p->kn[layer * 64 + j8 + e]; ig[e] = p->ikn[layer * 64 + j8 + e]; }
#define LD8(ptr, f) do { const uint4 q_ = *(const uint4*)(ptr); UNPK8(q_, f); } while (0)
#define ST8(ptr, f) do { uint4 q_; q_.x = pk2bf((f)[0], (f)[1]); q_.y = pk2bf((f)[2], (f)[3]); q_.z = pk2bf((f)[4], (f)[5]); q_.w = pk2bf((f)[6], (f)[7]); *(uint4*)(ptr) = q_; } while (0)
#define ST8F(ptr, f) do { *(float4*)(ptr) = make_float4((f)[0], (f)[1], (f)[2], (f)[3]); *(float4*)((ptr) + 4) = make_float4((f)[4], (f)[5], (f)[6], (f)[7]); } while (0)
#define HEADNORM(f, g) do { float ss_ = 0.f; _Pragma("unroll") for (int e = 0; e < 8; ++e) ss_ += (f)[e] * (f)[e]; ss_ += __shfl_xor(ss_, 1); ss_ += __shfl_xor(ss_, 2); ss_ += __shfl_xor(ss_, 4); \
        const float sc_ = rsqrtf(ss_ * (1.f / 64) + EPS); _Pragma("unroll") for (int e = 0; e < 8; ++e) (f)[e] = (f)[e] * sc_ * (g)[e]; } while (0)
#define ROPE8(f) do { _Pragma("unroll") for (int e = 0; e < 8; ++e) { const float o_ = __shfl_xor((f)[e], 4); (f)[e] = lowhalf ? (f)[e] * cs[e].x - o_ * cs[e].y : (f)[e] * cs[e].x + o_ * cs[e].y; } } while (0)
    for (int r = c.gwave; r < MT; r += c.nwaves) {
        const bool samp = r >= MP; int b, t, pos;
        if (!samp) { b = r >> 11; t = r & 2047; pos = t; } else { const int rr = r - MP; b = rr >> 4; t = rr & 15; pos = PAST + t; }
        const bf16_t* pr = praw + (size_t)r * NINP;
        float2 cs[8];
#pragma unroll
        for (int e = 0; e < 4; ++e) { const float4 q = *(const float4*)(rt + pos * 32 + (j8 & 31) + 2 * e); cs[2 * e] = make_float2(q.x, q.y); cs[2 * e + 1] = make_float2(q.z, q.w); }
        const size_t tok = samp ? (size_t)(layer * NB + b) * DSEQ + t : (size_t)(layer * NB + b) * SEQ + t;
        const size_t kpos = samp ? ((size_t)(layer * NB + b) * SKEYS + pos) : ((size_t)b * SEQ + pos);
        float f[8];
        LD8(pr + C_QA + lane * 8, f); HEADNORM(f, qg); ROPE8(f); ST8((bf16_t*)(p->ws + WS_QA) + (size_t)r * 512 + lane * 8, f);
        LD8(pr + C_QI + lane * 8, f); ROPE8(f); ST8((bf16_t*)(p->ws + WS_QI) + (size_t)r * 512 + lane * 8, f);
        {   const int col = lane < 32 ? C_KA + lane * 8 : (lane < 40 ? C_KI + (lane - 32) * 8 : C_WI);
            LD8(pr + col, f);
            float g[8];
#pragma unroll
            for (int e = 0; e < 8; ++e) g[e] = lane < 32 ? kg[e] : ig[e];
            float fn[8];
#pragma unroll
            for (int e = 0; e < 8; ++e) fn[e] = f[e];
            HEADNORM(fn, g); ROPE8(fn);
            if (lane < 16) { ST8F(p->out + (samp ? O_AKS : O_AKP) + tok * 128 + lane * 8, fn); ST8((bf16_t*)(p->ws + (samp ? WS_KAS : WS_KAP)) + kpos * 128 + lane * 8, fn); }

            else if (lane >= 32 && lane < 40) { ST8F(p->out + (samp ? O_IKS : O_IKP) + tok * 64 + (lane - 32) * 8, fn); ST8((bf16_t*)(p->ws + (samp ? WS_KIS : WS_KIP)) + kpos * 64 + (lane - 32) * 8, fn); }
            else if (lane == 40) { float* wo = (float*)(p->ws + WS_WI) + (size_t)r * 8;
#pragma unroll
                for (int e = 0; e < 8; ++e) f[e] *= (0.125f * 0.35355339059327373f);
                ST8F(wo, f); }
        }
    }
#undef LD8
#undef ST8
#undef ST8F
#undef HEADNORM
#undef ROPE8
}

__device__ __forceinline__ float ukey2f(unsigned k) { return (k & 0x80000000u) ? __uint_as_float(k ^ 0x80000000u) : __uint_as_float(~k); }
constexpr int DS_NSLOT = 17;
__device__ __forceinline__ void phase_dsa_select(PP p, const Ctx& c, int layer, int rep) {
    const int lane = c.lane, q = lane & 15, g = lane >> 4, wave = c.wave, tid = c.tid;
    int* cnt = (int*)c.lds;
    float* mmn = (float*)(c.lds + 3072); float* mmx = mmn + 128;
    unsigned* lmask = (unsigned*)(c.lds + 4096);
    unsigned* leq = (unsigned*)(c.lds + 8448);
    unsigned* M = (unsigned*)(p->ws + WS_MASK);
    const bf16_t* qiw = (const bf16_t*)(p->ws + WS_QI); const float* wiw = (const float*)(p->ws + WS_WI);
    unsigned* ctr = (unsigned*)(p->ws + WS_CTR) + (size_t)(layer * CTR_PER_LAYER + 120 + rep) * 64;
    int* tsel = (int*)(c.lds + 12800);
    for (;;) {
        if (tid == 0) *tsel = (int)__hip_atomic_fetch_add(ctr, 1u, __ATOMIC_RELAXED, __HIP_MEMORY_SCOPE_AGENT);
        __syncthreads();
        const int ord = *tsel;
        if (ord >= 1032) break;
        int tile;
        if (ord < 8) tile = 1024 + ord; else { const int i = ord - 8, cch = 31 - (i >> 5), j = i & 31; tile = (j >> 2) * 128 + cch * 4 + (j & 3); }
        int r0, n; const bf16_t* kI;
        if (tile < 1024) { const int b = tile >> 7, t0 = (tile & 127) * 16; r0 = tile * 16; n = ((t0 >> 6) + 1) * 64; kI = (const bf16_t*)(p->ws + WS_KIP) + (size_t)b * SEQ * 64; }
        else { const int b = tile - 1024; r0 = MP + b * 16; n = SKEYS; kI = (const bf16_t*)(p->ws + WS_KIS) + (size_t)(layer * NB + b) * SKEYS * 64; }
        const int ntiles = n >> 4;
        for (int i = tid; i < 768; i += 512) cnt[i] = 0;
        for (int i = tid; i < 65 * 16; i += 512) { lmask[i] = 0u; leq[i] = 0u; }
        __syncthreads();
        bf16x8 bq[8][2]; float w[8];
#pragma unroll
        for (int h = 0; h < 8; ++h) { w[h] = wiw[(size_t)(r0 + q) * 8 + h];
#pragma unroll
            for (int s = 0; s < 2; ++s) bq[h][s] = *(const bf16x8*)(qiw + (size_t)(r0 + q) * 512 + h * 64 + 32 * s + 8 * g); }
        float sc[DS_NSLOT][4];
#pragma unroll
        for (int i0 = 0; i0 < DS_NSLOT; i0 += 6) {
            bf16x8 ka[6][2];
#pragma unroll
            for (int ii = 0; ii < 6; ++ii) if (i0 + ii < DS_NSLOT) { const int kt = wave + 8 * (i0 + ii), ktc = kt < ntiles ? kt : ntiles - 1;
                ka[ii][0] = *(const bf16x8*)(kI + (size_t)(16 * ktc + q) * 64 + 8 * g); ka[ii][1] = *(const bf16x8*)(kI + (size_t)(16 * ktc + q) * 64 + 32 + 8 * g); }
            asm volatile("" ::: "memory");
#pragma unroll
            for (int ii = 0; ii < 6; ++ii) if (i0 + ii < DS_NSLOT) { const int i = i0 + ii, kt = wave + 8 * i;
                if (kt < ntiles) {
                    f32x4 s4 = {0.f, 0.f, 0.f, 0.f};
#pragma unroll
                    for (int h = 0; h < 8; ++h) { f32x4 a = {0.f, 0.f, 0.f, 0.f}; a = __builtin_amdgcn_mfma_f32_16x16x32_bf16(ka[ii][0], bq[h][0], a, 0, 0, 0); a = __builtin_amdgcn_mfma_f32_16x16x32_bf16(ka[ii][1], bq[h][1], a, 0, 0, 0);
#pragma unroll
                        for (int r = 0; r < 4; ++r) s4[r] += fmaxf(a[r], 0.f) * w[h]; }
#pragma unroll
                    for (int r = 0; r < 4; ++r) sc[i][r] = s4[r] + 0.f;
                } else {
#pragma unroll
                    for (int r = 0; r < 4; ++r) sc[i][r] = -__builtin_inff();
                } }
        }
        bool tie = false; float T = -__builtin_inff(), lo = 0.f; int chi = 0;
        if (n > TOPK) {
            float mn = __builtin_inff(), mx = -__builtin_inff();
#pragma unroll
            for (int i = 0; i < DS_NSLOT; ++i) if (wave + 8 * i < ntiles) {
#pragma unroll
                for (int r = 0; r < 4; ++r) { mn = fminf(mn, sc[i][r]); mx = fmaxf(mx, sc[i][r]); } }
            mn = fminf(mn, __shfl_xor(mn, 16)); mn = fminf(mn, __shfl_xor(mn, 32)); mx = fmaxf(mx, __shfl_xor(mx, 16)); mx = fmaxf(mx, __shfl_xor(mx, 32));
            if (g == 0) { mmn[wave * 16 + q] = mn; mmx[wave * 16 + q] = mx; }
            __syncthreads();
#pragma unroll
            for (int w8 = 0; w8 < 8; ++w8) { mn = fminf(mn, mmn[w8 * 16 + q]); mx = fmaxf(mx, mmx[w8 * 16 + q]); }
            lo = mn; float hi = ukey2f(fkey(mx) + 1u); bool done = false;
            for (int it = 0; it < 48; ++it) {
                const float mid = lo + 0.5f * (hi - lo);
                if (!done && !(mid > lo && mid < hi)) { done = true; tie = true; }
                if (__all(done)) break;
                int cl = 0;
#pragma unroll
                for (int i = 0; i < DS_NSLOT; ++i) if (wave + 8 * i < ntiles) {
#pragma unroll
                    for (int r = 0; r < 4; ++r) cl += (sc[i][r] >= mid) ? 1 : 0; }
                cl += __shfl_xor(cl, 16); cl += __shfl_xor(cl, 32);
                if (g == 0) atomicAdd(&cnt[it * 16 + q], cl);
                __syncthreads();
                const int ct = cnt[it * 16 + q];
                if (!done) { if (ct == TOPK) { done = true; T = mid; } else if (ct > TOPK) lo = mid; else { hi = mid; chi = ct; } }
            }
            if (tie) T = hi;
        }
#pragma unroll
        for (int i = 0; i < DS_NSLOT; ++i) {
            const int kt = wave + 8 * i;
            if (kt < ntiles) {
                unsigned nb = 0u, ne = 0u;
#pragma unroll
                for (int r = 0; r < 4; ++r) { nb |= (sc[i][r] >= T) ? (1u << r) : 0u; ne |= (tie && sc[i][r] == lo) ? (1u << r) : 0u; }
                nb <<= 4 * g; ne <<= 4 * g;
                nb |= __shfl_xor(nb, 16); nb |= __shfl_xor(nb, 32); ne |= __shfl_xor(ne, 16); ne |= __shfl_xor(ne, 32);
                if (g == 0) { atomicOr(&lmask[(kt >> 1) * 16 + q], nb << (16 * (kt & 1))); if (ne) atomicOr(&leq[(kt >> 1) * 16 + q], ne << (16 * (kt & 1))); }
            }
        }
        __syncthreads();
        if (wave == 0 && g == 0 && tie) { int need = TOPK - chi;
            for (int kg = 0; kg < 65 && need > 0; ++kg) { unsigned e = leq[kg * 16 + q]; unsigned add = 0u;
                while (e && need > 0) { const unsigned bit = e & (0u - e); add |= bit; e ^= bit; --need; }
                if (add) lmask[kg * 16 + q] |= add; } }
        __syncthreads();
        for (int i = tid; i < 65 * 16; i += 512) M[(size_t)(i >> 4) * MT + r0 + (i & 15)] = lmask[i];
        __syncthreads();
    }
}

constexpr int DA_ST = 8448, DA_NST = 4, DA_PD = 3;
__device__ __forceinline__ void phase_dsa_attn(PP p, const Ctx& c, int layer, int ctr_off) {
    const int lane = c.lane, ql = lane & 31, half = lane >> 5, wave = c.wave, tid = c.tid;
    unsigned* ctr = (unsigned*)(p->ws + WS_CTR) + (size_t)(layer * CTR_PER_LAYER + 32 + ctr_off * 40) * 64;
    const unsigned* M = (const unsigned*)(p->ws + WS_MASK); const bf16_t* qa = (const bf16_t*)(p->ws + WS_QA); bf16_t* oa = (bf16_t*)(p->ws + WS_OA);
    unsigned char* ring = c.lds; int* isel = (int*)(c.lds + DA_NST * DA_ST);
    const int hh = wave & 3, qq = wave >> 2;
    for (;;) {
        if (tid == 0) *isel = (int)__hip_atomic_fetch_add(ctr, 1u, __ATOMIC_RELAXED, __HIP_MEMORY_SCOPE_AGENT);
        __syncthreads();
        const int it = *isel;
        __syncthreads();
        if (it >= 16 + 512) break;
        int kvh, r0, ngrp, pitch, nq; const bf16_t *kA, *vT;
        if (it < 16) { const int b = it >> 1; kvh = it & 1; r0 = MP + b * 16; ngrp = 65; pitch = SKP; nq = 16;
            kA = (const bf16_t*)(p->ws + WS_KAS) + (size_t)(layer * NB + b) * SKEYS * 128; vT = (const bf16_t*)(p->ws + WS_VATS) + (size_t)((layer * NB + b) * 2 + kvh) * 64 * SKP; }
        else { const int j = it - 16, cch = 31 - (j >> 4), b = (j >> 1) & 7; kvh = j & 1; r0 = b * SEQ + cch * 64; ngrp = 2 * (cch + 1); pitch = SEQ; nq = 64;
            kA = (const bf16_t*)(p->ws + WS_KAP) + (size_t)b * SEQ * 128; vT = (const bf16_t*)(p->ws + WS_VAT) + (size_t)(b * 2 + kvh) * 64 * SEQ; }
        const int h = 4 * kvh + hh; const int qrow = nq == 64 ? r0 + 32 * qq + ql : r0 + (ql & 15); const bool active = nq == 64 || qq == 0; const bool store = nq == 64 || (qq == 0 && ql < 16);
        bf16x8 qf[4];
#pragma unroll
        for (int s = 0; s < 4; ++s) qf[s] = *(const bf16x8*)(qa + (size_t)qrow * 512 + h * 64 + 16 * s + 8 * half);
        asm volatile("s_waitcnt vmcnt(0)" ::: "memory");
        const int pk = (wave & 3) * 64 + lane;
        const bf16_t* gsrc; size_t gstep;
        if (wave < 4) { const int key = pk >> 3, pc = (pk & 7) ^ (key & 7); gsrc = kA + (size_t)key * 128 + kvh * 64 + pc * 8; gstep = (size_t)32 * 128; }
        else { const int d = pk >> 2, pc = (pk & 3) ^ ((d >> 2) & 3); gsrc = vT + (size_t)d * pitch + pc * 8; gstep = 32; }
        const unsigned* msrc = M + (nq == 64 ? r0 + lane : r0 + (lane & 15));
#define DA_ISSUE(g_) do { unsigned char* st_ = ring + ((g_) % DA_NST) * DA_ST; \
            __builtin_amdgcn_global_load_lds((const unsigned*)(gsrc + (size_t)(g_) * gstep), (LAS unsigned*)(st_ + wave * 1024), 16, 0, 0); \
            if (wave == 0) __builtin_amdgcn_global_load_lds(msrc + (size_t)(g_) * MT, (LAS unsigned*)(st_ + 8192), 4, 0, 0); } while (0)
#pragma unroll
        for (int g = 0; g < DA_PD; ++g) if (g < ngrp) DA_ISSUE(g);
        f32x16 o0, o1;
#pragma unroll
        for (int r = 0; r < 16; ++r) { o0[r] = 0.f; o1[r] = 0.f; }
        float mrun = -1.0e30f, l = 0.f;
        for (int kg = 0; kg < ngrp; ++kg) {
            if (kg + DA_PD - 1 < ngrp) { if (wave == 0) asm volatile("s_waitcnt vmcnt(4)" ::: "memory"); else asm volatile("s_waitcnt vmcnt(2)" ::: "memory"); }
            else asm volatile("s_waitcnt vmcnt(0)" ::: "memory");
            __builtin_amdgcn_s_barrier();
            if (kg + DA_PD < ngrp) DA_ISSUE(kg + DA_PD);
            if (active) {
                const unsigned char* st = ring + (kg % DA_NST) * DA_ST;
                const unsigned mw = *(const unsigned*)(st + 8192 + (nq == 64 ? 32 * qq + ql : (ql & 15)) * 4) >> (4 * half);
                f32x16 sacc;
#pragma unroll
                for (int r = 0; r < 16; ++r) sacc[r] = 0.f;
#pragma unroll
                for (int s = 0; s < 4; ++s) { const bf16x8 ka = *(const bf16x8*)(st + ql * 128 + (((2 * s + half) ^ (ql & 7)) * 16)); sacc = __builtin_amdgcn_mfma_f32_32x32x16_bf16(ka, qf[s], sacc, 0, 0, 0); }
                float sv[16]; float mt = -1.0e30f;
#pragma unroll
                for (int r = 0; r < 16; ++r) { const bool on = (mw >> (8 * (r >> 2) + (r & 3))) & 1u; sv[r] = on ? sacc[r] * 0.125f : -1.0e30f; mt = fmaxf(mt, sv[r]); }
                mt = fmaxf(mt, __shfl_xor(mt, 32));
                const float mnew = fmaxf(mrun, mt), alpha = __expf(mrun - mnew); mrun = mnew;
                float pr[16], ls = 0.f;
#pragma unroll
                for (int r = 0; r < 16; ++r) { const bool on = (mw >> (8 * (r >> 2) + (r & 3))) & 1u; pr[r] = on ? __expf(sv[r] - mnew) : 0.f; ls += pr[r]; }
                l = l * alpha + ls;
                if (!__all(alpha == 1.f)) {
#pragma unroll
                    for (int r = 0; r < 16; ++r) { o0[r] *= alpha; o1[r] *= alpha; } }
#pragma unroll
                for (int s2 = 0; s2 < 2; ++s2) {
                    u32x4v pw; pw.x = pg8::cvt_pk_bf16(pr[8 * s2], pr[8 * s2 + 1]); pw.y = pg8::cvt_pk_bf16(pr[8 * s2 + 2], pr[8 * s2 + 3]); pw.z = pg8::cvt_pk_bf16(pr[8 * s2 + 4], pr[8 * s2 + 5]); pw.w = pg8::cvt_pk_bf16(pr[8 * s2 + 6], pr[8 * s2 + 7]);
                    const bf16x8 pb = __builtin_bit_cast(bf16x8, pw);
                    const int d0 = ql, d1 = 32 + ql;
                    const bf16x8 va0 = *(const bf16x8*)(st + 4096 + d0 * 64 + (((2 * s2 + half) ^ ((d0 >> 2) & 3)) * 16));
                    const bf16x8 va1 = *(const bf16x8*)(st + 4096 + d1 * 64 + (((2 * s2 + half) ^ ((d1 >> 2) & 3)) * 16));
                    o0 = __builtin_amdgcn_mfma_f32_32x32x16_bf16(va0, pb, o0, 0, 0, 0); o1 = __builtin_amdgcn_mfma_f32_32x32x16_bf16(va1, pb, o1, 0, 0, 0); }
            }
        }
#undef DA_ISSUE
        l += __shfl_xor(l, 32); const float inv = 1.f / l;
        if (store) { bf16_t* orow = oa + (size_t)qrow * 512 + h * 64;
#pragma unroll
            for (int a = 0; a < 4; ++a) { u32x2v w0, w1; const int d = 8 * a + 4 * half;
                w0.x = pk2bf(o0[4 * a] * inv, o0[4 * a + 1] * inv); w0.y = pk2bf(o0[4 * a + 2] * inv, o0[4 * a + 3] * inv); w1.x = pk2bf(o1[4 * a] * inv, o1[4 * a + 1] * inv); w1.y = pk2bf(o1[4 * a + 2] * inv, o1[4 * a + 3] * inv);
                *(u32x2v*)(orow + d) = w0; *(u32x2v*)(orow + 32 + d) = w1; } }
        asm volatile("s_waitcnt vmcnt(0)" ::: "memory");
        __syncthreads();
    }
}

__device__ __forceinline__ float sb_tail_row(PP p, int layer, int b, int h, int r, int nk, float* qf, int lane) {
    WSYNC(); qf[lane] = bf2f(((const bf16_t*)(p->ws + WS_QB))[(size_t)r * 512 + h * 64 + lane]); WSYNC();
    const float* kBc = p->cache_b_k + ((size_t)(layer * NB + b) * PAST) * 512 + h * 64; const float* vBc = p->cache_b_v + ((size_t)(layer * NB + b) * PAST) * 512 + h * 64;
    float carry = 0.f, o = 0.f;
    for (int top = nk - 1; top >= 0; top -= 64) {
        const int s = top - lane; const bool valid = s >= 0; float z = 0.f;
        if (valid) { const float4* kr = (const float4*)(kBc + (size_t)s * 512);
#pragma unroll
            for (int c4 = 0; c4 < 16; ++c4) { const float4 kv = kr[c4]; z += qf[c4 * 4] * kv.x + qf[c4 * 4 + 1] * kv.y + qf[c4 * 4 + 2] * kv.z + qf[c4 * 4 + 3] * kv.w; }
            z *= 0.125f; }
        const float lr = valid ? -softplusf(z) : 0.f;
        float inc = lr;
#pragma unroll
        for (int off = 1; off < 64; off <<= 1) { const float t = __shfl_up(inc, off); if (lane >= off) inc += t; }
        const float after = carry + inc - lr;
        const float att = valid ? __expf(-softplusf(-z) + after) : 0.f;
        const int cnt = top + 1 < 64 ? top + 1 : 64;
        for (int j = 0; j < cnt; ++j) { const float a = rdlane(att, j); o += a * vBc[(size_t)(top - j) * 512 + lane]; }
        carry += rdlane(inc, 63);
        if (carry < -104.f) break;
    }
    return o;
}

__device__ __forceinline__ void phase_sb_mfma(PP p, const Ctx& c, int layer) {
    const int lane = c.lane, ql = lane & 31, half = lane >> 5;
    const bf16_t* qb = (const bf16_t*)(p->ws + WS_QB); const bf16_t* kB = (const bf16_t*)(p->ws + WS_KBP); const bf16_t* vT = (const bf16_t*)(p->ws + WS_VBT); bf16_t* ob = (bf16_t*)(p->ws + WS_OB);
    for (int item = c.gwave; item < NB * 8 * 64 + 64; item += c.nwaves) {
        const bool samp = item >= NB * 8 * 64;
        const int h = item & 7, b = (item >> 3) & 7; const int qt = samp ? 7 : 63 - (item >> 6), q0 = qt * 32;
        const int qpos = samp ? SBT + (ql & 15) : q0 + ql; const size_t qrow = samp ? (size_t)MP + b * DSEQ + (ql & 15) : (size_t)b * SEQ + q0 + ql;
        const bf16_t* kBi = samp ? (const bf16_t*)(p->ws + WS_KBS) + (size_t)(layer * NB + b) * SBL * 512 : kB + (size_t)b * SEQ * 512;
        const bf16_t* vTi = samp ? (const bf16_t*)(p->ws + WS_VBTS) + (size_t)((layer * NB + b) * 8 + h) * 64 * SBL : vT + (size_t)(b * 8 + h) * 64 * SEQ;
        const int vpitch = samp ? SBL : SEQ;
        bf16x8 qf[4];
#pragma unroll
        for (int s = 0; s < 4; ++s) qf[s] = *(const bf16x8*)(qb + qrow * 512 + h * 64 + 16 * s + 8 * half);
        f32x16 o0, o1;
#pragma unroll
        for (int r = 0; r < 16; ++r) { o0[r] = 0.f; o1[r] = 0.f; }
        float carry = 1.f;
        for (int kt = qt; kt >= 0; --kt) {
            const int k0 = kt * 32;
            f32x16 st;
#pragma unroll
            for (int r = 0; r < 16; ++r) st[r] = 0.f;
#pragma unroll
            for (int s = 0; s < 4; ++s) { const bf16x8 ka = *(const bf16x8*)(kBi + (size_t)(k0 + ql) * 512 + h * 64 + 16 * s + 8 * half); st = __builtin_amdgcn_mfma_f32_32x32x16_bf16(ka, qf[s], st, 0, 0, 0); }
            float om[16], sg[16];
#pragma unroll
            for (int r = 0; r < 16; ++r) { const int key = k0 + 8 * (r >> 2) + 4 * half + (r & 3); const bool valid = key < qpos;
                float z = st[r] * 0.125f; z = fminf(fmaxf(z, -80.f), 80.f); const float e = __expf(z); const float rr = __builtin_amdgcn_rcpf(1.f + e);
                om[r] = valid ? rr : 1.f; sg[r] = valid ? e * rr : 0.f; }
            float G[4], Go[4];
#pragma unroll
            for (int a = 0; a < 4; ++a) { G[a] = (om[4 * a] * om[4 * a + 1]) * (om[4 * a + 2] * om[4 * a + 3]); Go[a] = __shfl_xor(G[a], 32); }
            float suf = 1.f; float att[16];
#pragma unroll
            for (int a = 3; a >= 0; --a) { const float Sa = (half == 0 ? suf * Go[a] : suf) * carry;
                const float R3 = Sa, R2 = R3 * om[4 * a + 3], R1 = R2 * om[4 * a + 2], R0 = R1 * om[4 * a + 1];
                att[4 * a + 3] = sg[4 * a + 3] * R3; att[4 * a + 2] = sg[4 * a + 2] * R2; att[4 * a + 1] = sg[4 * a + 1] * R1; att[4 * a] = sg[4 * a] * R0;
                suf = suf * (G[a] * Go[a]); }
            carry *= suf;
#pragma unroll
            for (int s2 = 0; s2 < 2; ++s2) {
                u32x4v pw; pw.x = pg8::cvt_pk_bf16(att[8 * s2], att[8 * s2 + 1]); pw.y = pg8::cvt_pk_bf16(att[8 * s2 + 2], att[8 * s2 + 3]); pw.z = pg8::cvt_pk_bf16(att[8 * s2 + 4], att[8 * s2 + 5]); pw.w = pg8::cvt_pk_bf16(att[8 * s2 + 6], att[8 * s2 + 7]);
                const bf16x8 pb = __builtin_bit_cast(bf16x8, pw);
                const bf16x8 va0 = *(const bf16x8*)(vTi + (size_t)ql * vpitch + k0 + 16 * s2 + 8 * half);
                const bf16x8 va1 = *(const bf16x8*)(vTi + (size_t)(32 + ql) * vpitch + k0 + 16 * s2 + 8 * half);
                o0 = __builtin_amdgcn_mfma_f32_32x32x16_bf16(va0, pb, o0, 0, 0, 0); o1 = __builtin_amdgcn_mfma_f32_32x32x16_bf16(va1, pb, o1, 0, 0, 0); }
            if (__all(carry == 0.f)) break;
        }
        if (!samp || ql < 16) { bf16_t* orow = ob + qrow * 512 + h * 64;
#pragma unroll
            for (int a = 0; a < 4; ++a) { u32x2v w0, w1; const int d = 8 * a + 4 * half;
                w0.x = pk2bf(o0[4 * a], o0[4 * a + 1]); w0.y = pk2bf(o0[4 * a + 2], o0[4 * a + 3]); w1.x = pk2bf(o1[4 * a], o1[4 * a + 1]); w1.y = pk2bf(o1[4 * a + 2], o1[4 * a + 3]);
                *(u32x2v*)(orow + d) = w0; *(u32x2v*)(orow + 32 + d) = w1; } }
        if (samp && !__all(carry == 0.f)) {
            asm volatile("s_waitcnt vmcnt(0)" ::: "memory");
            for (int qi = 0; qi < 16; ++qi) { const float cq = rdlane(carry, qi); if (cq == 0.f) continue;
                const int r = MP + b * DSEQ + qi; const float orest = sb_tail_row(p, layer, b, h, r, PAST - SBT, (float*)c.lds + c.wave * 64, lane);
                bf16_t* o1p = ob + (size_t)r * 512 + h * 64 + lane; *o1p = f2bf(bf2f(*o1p) + cq * orest); }
        }
    }
}

#define CEX(x, y) do { const unsigned lo_ = __builtin_elementwise_min(x, y), hi_ = __builtin_elementwise_max(x, y); x = lo_; y = hi_; } while (0)
template <bool DESC> __device__ __forceinline__ void bitonic_sort16(unsigned (&a)[16]) {
#pragma unroll
    for (int k = 2; k <= 16; k <<= 1)
#pragma unroll
        for (int j = k >> 1; j > 0; j >>= 1)
#pragma unroll
            for (int i = 0; i < 16; ++i) { const int l = i ^ j; if (l > i) { const bool up = (((i & k) == 0) != DESC); if (up) CEX(a[i], a[l]); else CEX(a[l], a[i]); } }
}
__device__ __forceinline__ void bitonic_merge16_desc(unsigned (&a)[16]) {
#pragma unroll
    for (int j = 8; j > 0; j >>= 1)
#pragma unroll
        for (int i = 0; i < 16; ++i) { const int l = i ^ j; if (l > i) CEX(a[l], a[i]); }
}
__device__ __forceinline__ void phase_peer_select(PP p, const Ctx& c) {
    const int lane = c.lane, sub = lane & 7; const float* sT = (const float*)(p->ws + WS_PRAW);
    float* tvl = (float*)c.lds + (size_t)c.wave * 4096 + lane; int* til = (int*)c.lds + (size_t)c.wave * 4096 + 2048 + lane;
    for (int task = c.gwave; task < MS; task += c.nwaves) {
        const int pr = task * 8 + (lane >> 3), h = pr & 7, tok = MP + (pr >> 3);
        float tv[2][16];
#pragma unroll
        for (int side = 0; side < 2; ++side) {
            const float* base = sT + (size_t)(h * 256 + side * 128) * MT + tok;
            unsigned top[16];
#pragma unroll
            for (int i = 0; i < 16; ++i) top[i] = (fkey(base[(size_t)(sub * 16 + i) * MT]) & ~127u) | (unsigned)(127 - sub * 16 - i);
            bitonic_sort16<true>(top);
#pragma unroll
            for (int mk = 1; mk < 8; mk <<= 1) {
                unsigned o[16];
#pragma unroll
                for (int i = 0; i < 16; ++i) o[i] = (unsigned)__shfl_xor((int)top[15 - i], mk);
#pragma unroll
                for (int i = 0; i < 16; ++i) top[i] = __builtin_elementwise_max(top[i], o[i]);
                bitonic_merge16_desc(top); }
#pragma unroll
            for (int i = 0; i < 16; ++i) { const int k = 127 - (int)(top[i] & 127u); const float ex = base[(size_t)k * MT]; til[(side * 16 + i) * 64] = k; tvl[(side * 16 + i) * 64] = ex; tv[side][i] = ex; }
        }
        unsigned top[16];
#pragma unroll
        for (int g = 0; g < 4; ++g) {
            unsigned s[16];
#pragma unroll
            for (int i = 0; i < 16; ++i) s[i] = 0u;
            { int cnt = 0;
#pragma unroll
              for (int a = 0; a < 16; ++a)
#pragma unroll
                for (int b = 0; b < 16; ++b) if ((a + 1) * (b + 1) <= 16) { if (cnt / 16 == g) s[cnt % 16] = (fkey(tv[0][a] + tv[1][b]) & ~255u) | (unsigned)(255 - (a * 16 + b)); ++cnt; } }
            if (g == 0) { bitonic_sort16<true>(s);
#pragma unroll
                for (int i = 0; i < 16; ++i) top[i] = s[i]; }
            else { bitonic_sort16<false>(s);
#pragma unroll
                for (int i = 0; i < 16; ++i) top[i] = __builtin_elementwise_max(top[i], s[i]);
                bitonic_merge16_desc(top); }
        }
        float cv[16]; int ce[16];
#pragma unroll
        for (int i = 0; i < 16; ++i) { const int cc = 255 - (int)(top[i] & 255u), a = cc >> 4, b = cc & 15; cv[i] = tvl[a * 64] + tvl[(16 + b) * 64]; ce[i] = til[a * 64] * 128 + til[(16 + b) * 64]; }
        float mx = cv[0];
#pragma unroll
        for (int i = 1; i < 16; ++i) mx = fmaxf(mx, cv[i]);
        float ev[16], sm = 0.f;
#pragma unroll
        for (int i = 0; i < 16; ++i) { ev[i] = __expf(cv[i] - mx); sm += ev[i]; }
        const float inv = 1.f / sm;
        int* eo = (int*)(p->ws + WS_EID) + (size_t)tok * 128 + h * 16; float* go = (float*)(p->ws + WS_GW) + (size_t)tok * 128 + h * 16;
        if (sub == 0) {
#pragma unroll
            for (int j = 0; j < 4; ++j) { *(int4*)(eo + 4 * j) = make_int4(ce[4 * j], ce[4 * j + 1], ce[4 * j + 2], ce[4 * j + 3]);
                *(float4*)(go + 4 * j) = make_float4(ev[4 * j] * inv, ev[4 * j + 1] * inv, ev[4 * j + 2] * inv, ev[4 * j + 3] * inv); } }
    }
}

constexpr int PE_CHUNK = 8, PE_NCHUNK = MT / PE_CHUNK, PE_NSL = 8;
__device__ __forceinline__ unsigned wave_dequeue(unsigned* ctr, int lane) {
    unsigned v = 0u; if (lane == 0) v = __hip_atomic_fetch_add(ctr, 1u, __ATOMIC_RELAXED, __HIP_MEMORY_SCOPE_AGENT);
    return (unsigned)__builtin_amdgcn_readfirstlane((int)v);
}
constexpr int PEU_DQ = 4; constexpr int PEU_TOK = 4, PEU_NCHUNK = MT / PEU_TOK, PEU_XS = 1088, PEU_WL = 8192 + PEU_TOK * PEU_XS;
#define PEU_LOAD(ua_, j0_) do { \
    const int ia_ = (j0_) + q; const int ex_ = list[ia_ < n ? ia_ : n - 1] >> 9; \
    const unsigned char* ur_ = U8 + (size_t)ex_ * D + 16 * g; \
    _Pragma("unroll") for (int sp = 0; sp < 16; ++sp) ua_[sp] = *(const uint4*)(ur_ + 64 * sp); } while (0)
#define PEU_MMA(ua_, j0_) do { \
    const int ib_ = (j0_) + q; const int ic_ = ib_ < n ? ib_ : n - 1; const int ent_ = list[ic_]; \
    const unsigned char* xr_ = xl + ((ent_ >> 7) & 3) * PEU_XS + 16 * g; \
    f32x4 acc_ = {0.f, 0.f, 0.f, 0.f}; \
    _Pragma("unroll") for (int sp = 0; sp < 16; ++sp) { const uint4 xq_ = *(const uint4*)(xr_ + 64 * sp); \
        const long alo_ = (long)(((unsigned long long)ua_[sp].y << 32) | ua_[sp].x), ahi_ = (long)(((unsigned long long)ua_[sp].w << 32) | ua_[sp].z); \
        const long blo_ = (long)(((unsigned long long)xq_.y << 32) | xq_.x), bhi_ = (long)(((unsigned long long)xq_.w << 32) | xq_.z); \
        acc_ = __builtin_amdgcn_mfma_f32_16x16x32_fp8_fp8(alo_, blo_, acc_, 0, 0, 0); acc_ = __builtin_amdgcn_mfma_f32_16x16x32_fp8_fp8(ahi_, bhi_, acc_, 0, 0, 0); } \
      \
    const bool live_ = (g == (q >> 2)) && ib_ < n; \
    const float dsel_ = (q & 3) == 0 ? acc_[0] : ((q & 3) == 1 ? acc_[1] : ((q & 3) == 2 ? acc_[2] : acc_[3])); \
    const float dot_ = dsel_ * lsu[ic_]; \
    const float cf_ = lg[ic_] * 0.5f * dot_ * (1.f + erff(dot_ * 0.70710678118654752f)) * lsv[ic_]; \
    if (rep == 0) { if (live_) gw[(size_t)(rbeg + ((ent_ >> 7) & 3)) * 128 + (ent_ & 127)] = cf_; } else asm volatile("" :: "v"(cf_)); } while (0)
__device__ __forceinline__ void phase_peer_u(PP p, const Ctx& c, int layer, int rep) {
    const int lane = c.lane, g = lane >> 4, q = lane & 15; const unsigned char* U8 = p->ws + WS_U8 + (size_t)layer * NEXP * D; const unsigned char* X8 = p->ws + WS_X8;
    const float* sui = (const float*)(p->ws + WS_SUI) + (size_t)layer * NEXP; const float* svi = (const float*)(p->ws + WS_SVI) + (size_t)layer * NEXP;
    int* list = (int*)(c.lds + (size_t)c.wave * PEU_WL); float* lg = (float*)(list + 512); float* lsu = lg + 512; float* lsv = lsu + 512; unsigned char* xl = (unsigned char*)(list + 2048);
    const int* eid = (const int*)(p->ws + WS_EID); float* gw = (float*)(p->ws + WS_GW);
    const int xcc = (int)xb_xcc_id();
    for (int pass = 0; pass < PE_NSL; ++pass) {
        const int s = (xcc + pass) & (PE_NSL - 1);
        unsigned* ctr = (unsigned*)(p->ws + WS_CTR) + (size_t)(layer * CTR_PER_LAYER + rep * 40 + s) * 64;
        for (;;) {
            const unsigned chunk = wave_dequeue(ctr, lane); if (chunk >= (unsigned)(PEU_NCHUNK / PEU_DQ)) break;
            int en[8];
            { const size_t rb0 = (size_t)chunk * PEU_DQ * PEU_TOK;
#pragma unroll
              for (int t = 0; t < PEU_TOK; ++t) { en[2 * t] = eid[(rb0 + t) * 128 + lane]; en[2 * t + 1] = eid[(rb0 + t) * 128 + 64 + lane]; } }
            for (int sub = 0; sub < PEU_DQ; ++sub) {
            const int rbeg = ((int)chunk * PEU_DQ + sub) * PEU_TOK;
            const int e00 = en[0], e01 = en[1], e10 = en[2], e11 = en[3], e20 = en[4], e21 = en[5], e30 = en[6], e31 = en[7];
            { const size_t rbn = (size_t)(rbeg + PEU_TOK < MT ? rbeg + PEU_TOK : rbeg);
#pragma unroll
              for (int t = 0; t < PEU_TOK; ++t) { en[2 * t] = eid[(rbn + t) * 128 + lane]; en[2 * t + 1] = eid[(rbn + t) * 128 + 64 + lane]; } }
            const uint4 x0 = *(const uint4*)(X8 + (size_t)rbeg * D + lane * 16), x1 = *(const uint4*)(X8 + (size_t)(rbeg + 1) * D + lane * 16), x2 = *(const uint4*)(X8 + (size_t)(rbeg + 2) * D + lane * 16), x3 = *(const uint4*)(X8 + (size_t)(rbeg + 3) * D + lane * 16);
            WSYNC();
            *(uint4*)(xl + lane * 16) = x0; *(uint4*)(xl + PEU_XS + lane * 16) = x1; *(uint4*)(xl + 2 * PEU_XS + lane * 16) = x2; *(uint4*)(xl + 3 * PEU_XS + lane * 16) = x3;
            const int e[PEU_TOK][2] = {{e00, e01}, {e10, e11}, {e20, e21}, {e30, e31}};
            int n = 0;
#pragma unroll
            for (int t = 0; t < PEU_TOK; ++t) {
#pragma unroll
                for (int v = 0; v < 2; ++v) { const int ee = e[t][v]; const bool in = (ee >> 11) == s; const unsigned long long mk = __ballot(in);
                    if (in) { const int pos = n + lane_prefix(mk); list[pos] = (lane + 64 * v) | (t << 7) | (ee << 9); lg[pos] = gw[(size_t)(rbeg + t) * 128 + lane + 64 * v]; lsu[pos] = sui[ee]; lsv[pos] = svi[ee]; }
                    n += __popcll(mk); } }
            WSYNC();
            if (n == 0) continue;
#ifdef UPROBE_FRONT_ONLY
            if (rep != 0) { asm volatile("" :: "v"(n)); continue; }
#endif
            uint4 ua0[16], ua1[16];
            PEU_LOAD(ua0, 0);
            for (int j0 = 0; j0 < n; j0 += 32) {
                const bool has1 = j0 + 16 < n;
                if (has1) PEU_LOAD(ua1, j0 + 16);
                asm volatile("" ::: "memory");
                PEU_MMA(ua0, j0);
                if (has1) {
                    if (j0 + 32 < n) PEU_LOAD(ua0, j0 + 32);
                    asm volatile("" ::: "memory");
                    PEU_MMA(ua1, j0 + 16);
                }
            }
            }
        }
    }
}
#undef PEU_LOAD
#undef PEU_MMA
#define PEV_IDXE(ev_, r_) do { const int rr_ = (r_) < MT ? (r_) : MT - 1; _Pragma("unroll") for (int j = 0; j < 4; ++j) { const int4 e4 = *(const int4*)(eid + (size_t)rr_ * 128 + pg * 16 + j * 4); \
        ev_[j * 4] = e4.x; ev_[j * 4 + 1] = e4.y; ev_[j * 4 + 2] = e4.z; ev_[j * 4 + 3] = e4.w; } } while (0)
#define PEV_IDXC(cv_, r_) do { const int rr_ = (r_) < MT ? (r_) : MT - 1; _Pragma("unroll") for (int j = 0; j < 4; ++j) { const float4 c4 = *(const float4*)(gw + (size_t)rr_ * 128 + pg * 16 + j * 4); \
        cv_[j * 4] = c4.x; cv_[j * 4 + 1] = c4.y; cv_[j * 4 + 2] = c4.z; cv_[j * 4 + 3] = c4.w; } } while (0)
#define PEV_LOADV(vq_, ev_) do { _Pragma("unroll") for (int j = 0; j < 16; ++j) vq_[j] = *(const uint4*)(Vs + (size_t)ev_[j] * 128); } while (0)
#define PEV_FINISH(vq_, cv_, r_) do { \
    float* xr_ = p->out + (size_t)(r_) * D + s * 128 + ch * 16 + ((lane >> 5) & 1) * 8 + ((lane >> 4) & 1) * 4 + ((lane >> 3) & 1) * 2; const float2 xold_ = *(const float2*)xr_; \
    float acc[16]; \
    _Pragma("unroll") for (int e = 0; e < 16; ++e) acc[e] = 0.f; \
    _Pragma("unroll") for (int j = 0; j < 16; ++j) { const unsigned w4[4] = {vq_[j].x, vq_[j].y, vq_[j].z, vq_[j].w}; \
        _Pragma("unroll") for (int k = 0; k < 4; ++k) { const f32x2v lo = __builtin_amdgcn_cvt_pk_f32_fp8((int)w4[k], false), hi = __builtin_amdgcn_cvt_pk_f32_fp8((int)w4[k], true); \
            acc[4 * k] += cv_[j] * lo.x; acc[4 * k + 1] += cv_[j] * lo.y; acc[4 * k + 2] += cv_[j] * hi.x; acc[4 * k + 3] += cv_[j] * hi.y; } \
        if ((j & 1) == 1) asm volatile("" : "+v"(acc[0]), "+v"(acc[1]), "+v"(acc[2]), "+v"(acc[3]), "+v"(acc[4]), "+v"(acc[5]), "+v"(acc[6]), "+v"(acc[7]), "+v"(acc[8]), "+v"(acc[9]), "+v"(acc[10]), "+v"(acc[11]), "+v"(acc[12]), "+v"(acc[13]), "+v"(acc[14]), "+v"(acc[15])); } \
    { const bool hi = (lane & 32) != 0; _Pragma("unroll") for (int k = 0; k < 8; ++k) { const float snd = hi ? acc[k] : acc[k + 8]; const float rcv = __shfl_xor(snd, 32); acc[k] = (hi ? acc[k + 8] : acc[k]) + rcv; } } \
    { const bool hi = (lane & 16) != 0; _Pragma("unroll") for (int k = 0; k < 4; ++k) { const float snd = hi ? acc[k] : acc[k + 4]; const float rcv = __shfl_xor(snd, 16); acc[k] = (hi ? acc[k + 4] : acc[k]) + rcv; } } \
    { const bool hi = (lane & 8) != 0; _Pragma("unroll") for (int k = 0; k < 2; ++k) { const float snd = hi ? acc[k] : acc[k + 2]; const float rcv = __shfl_xor(snd, 8); acc[k] = (hi ? acc[k + 2] : acc[k]) + rcv; } } \
    if (rep != 0) { asm volatile("" :: "v"(acc[0]), "v"(acc[1]), "v"(xold_.x)); } else { *(float2*)xr_ = make_float2(xold_.x + acc[0], xold_.y + acc[1]); } } while (0)
__device__ __forceinline__ void phase_peer_v(PP p, const Ctx& c, int layer, int rep) {
    const int lane = c.lane, pg = lane >> 3, ch = lane & 7; const unsigned char* V8 = p->ws + WS_V8 + (size_t)layer * NEXP * D;
    const int* eid = (const int*)(p->ws + WS_EID); const float* gw = (const float*)(p->ws + WS_GW);
    const int xcc = (int)xb_xcc_id();
    for (int pass = 0; pass < PE_NSL; ++pass) {
        const int s = (xcc + pass) & (PE_NSL - 1);
        unsigned* ctr = (unsigned*)(p->ws + WS_CTR) + (size_t)(layer * CTR_PER_LAYER + rep * 40 + 16 + s) * 64;
        for (;;) {
            const unsigned chunk = wave_dequeue(ctr, lane); if (chunk >= (unsigned)PE_NCHUNK) break;
            const unsigned char* Vs = V8 + (size_t)s * NEXP * 128 + ch * 16;
            const int rbeg = (int)chunk * PE_CHUNK;
            int evA[16], evB[16]; float cvA[16], cvB[16]; uint4 vqA[16], vqB[16];
            PEV_IDXE(evA, rbeg); PEV_IDXC(cvA, rbeg); PEV_IDXE(evB, rbeg + 1); PEV_IDXC(cvB, rbeg + 1);
            PEV_LOADV(vqA, evA);
            PEV_IDXE(evA, rbeg + 2);
            for (int r = rbeg; r < rbeg + PE_CHUNK; r += 2) {
                PEV_LOADV(vqB, evB); PEV_IDXE(evB, r + 3);
                asm volatile("" ::: "memory");
                PEV_FINISH(vqA, cvA, r);
                PEV_IDXC(cvA, r + 2);
                if (r + 2 < rbeg + PE_CHUNK) { PEV_LOADV(vqA, evA); PEV_IDXE(evA, r + 4); }
                asm volatile("" ::: "memory");
                PEV_FINISH(vqB, cvB, r + 1);
                PEV_IDXC(cvB, r + 3);
            }
        }
    }
}
#undef PEV_IDXE
#undef PEV_IDXC
#undef PEV_LOADV
#undef PEV_FINISH

struct EPraw { unsigned char* ws; float* out; int layer;
    __device__ __forceinline__ void vt_store(bf16_t* base  , int pitch, int cc, int pos, f32x4 v) const {
        const int o16 = pos & 15, pp = (pos & ~15) + 8 * ((o16 >> 2) & 1) + 4 * (o16 >> 3) + (o16 & 3);
#pragma unroll
        for (int i = 0; i < 4; ++i) base[(size_t)(cc + i) * pitch + pp] = f2bf(v[i]); }
    __device__ __forceinline__ void store4(int row, int col, f32x4 v) const {
        if (col >= C_GA) { if (col >= C_GA + 2 * D) return;
            u32x2v w; w.x = pk2bf(__builtin_amdgcn_rcpf(1.f + __expf(-v[0])), __builtin_amdgcn_rcpf(1.f + __expf(-v[1]))); w.y = pk2bf(__builtin_amdgcn_rcpf(1.f + __expf(-v[2])), __builtin_amdgcn_rcpf(1.f + __expf(-v[3])));
            bf16_t* dst = col >= C_GB ? (bf16_t*)(ws + WS_SGB) + (size_t)row * D + (col - C_GB) : (bf16_t*)(ws + WS_SGA) + (size_t)row * D + (col - C_GA); *(u32x2v*)dst = w; return; }
        u32x2v w; w.x = pk2bf(v[0], v[1]); w.y = pk2bf(v[2], v[3]);
        const bool samp = row >= MP; const int rs = row - MP;
        if (col >= C_QB) {
            if (col < C_KB) { *(u32x2v*)((bf16_t*)(ws + WS_QB) + (size_t)row * 512 + (col - C_QB)) = w; return; }
            if (col < C_VB) { const int cc = col - C_KB;
                *(f32x4*)(out + (samp ? O_BKS + ((size_t)layer * MS + rs) * 512 : O_BKP + ((size_t)layer * MP + row) * 512) + cc) = v;
                *(u32x2v*)((samp ? (bf16_t*)(ws + WS_KBS) + ((size_t)(layer * NB + (rs >> 4)) * SBL + SBT + (rs & 15)) * 512 : (bf16_t*)(ws + WS_KBP) + (size_t)row * 512) + cc) = w; return; }
            const int cc = col - C_VB;
            *(f32x4*)(out + (samp ? O_BVS + ((size_t)layer * MS + rs) * 512 : O_BVP + ((size_t)layer * MP + row) * 512) + cc) = v;
            if (samp) vt_store((bf16_t*)(ws + WS_VBTS) + (size_t)(layer * NB + (rs >> 4)) * 8 * 64 * SBL, SBL, cc, SBT + (rs & 15), v); else vt_store((bf16_t*)(ws + WS_VBT) + (size_t)(row >> 11) * 8 * 64 * SEQ, SEQ, cc, row & 2047, v);
            return;
        }
        if (col >= C_VA && col < C_QI) { const int cc = col - C_VA;
            *(f32x4*)(out + (samp ? O_AVS + ((size_t)layer * MS + rs) * 128 : O_AVP + ((size_t)layer * MP + row) * 128) + cc) = v;
            if (samp) vt_store((bf16_t*)(ws + WS_VATS) + (size_t)(layer * NB + (rs >> 4)) * 2 * 64 * SKP, SKP, cc, PAST + (rs & 15), v); else vt_store((bf16_t*)(ws + WS_VAT) + (size_t)(row >> 11) * 2 * 64 * SEQ, SEQ, cc, row & 2047, v);
            return; }
        *(u32x2v*)((bf16_t*)(ws + WS_PRAW) + (size_t)row * NINP + col) = w; }
    __device__ __forceinline__ void store8(int row, int col, f32x4 v0, f32x4 v1) const {
        if (col >= C_GA) { if (col >= C_GA + 2 * D) return;
            uint4 w; w.x = pk2bf(__builtin_amdgcn_rcpf(1.f + __expf(-v0[0])), __builtin_amdgcn_rcpf(1.f + __expf(-v0[1]))); w.y = pk2bf(__builtin_amdgcn_rcpf(1.f + __expf(-v0[2])), __builtin_amdgcn_rcpf(1.f + __expf(-v0[3])));
            w.z = pk2bf(__builtin_amdgcn_rcpf(1.f + __expf(-v1[0])), __builtin_amdgcn_rcpf(1.f + __expf(-v1[1]))); w.w = pk2bf(__builtin_amdgcn_rcpf(1.f + __expf(-v1[2])), __builtin_amdgcn_rcpf(1.f + __expf(-v1[3])));
            bf16_t* dst = col >= C_GB ? (bf16_t*)(ws + WS_SGB) + (size_t)row * D + (col - C_GB) : (bf16_t*)(ws + WS_SGA) + (size_t)row * D + (col - C_GA); *(uint4*)dst = w; return; }
        store4(row, col, v0); store4(row, col + 4, v1); } };
struct EGate { bf16_t* o; const bf16_t* g; const bf16_t* add;
    __device__ __forceinline__ void store4(int row, int col, f32x4 v) const { const size_t i = (size_t)row * D + col; const u32x2v gw = *(const u32x2v*)(g + i);
        float r0 = __uint_as_float(gw.x << 16) * v[0], r1 = __uint_as_float(gw.x & 0xFFFF0000u) * v[1], r2 = __uint_as_float(gw.y << 16) * v[2], r3 = __uint_as_float(gw.y & 0xFFFF0000u) * v[3];
        if (add) { const u32x2v aw = *(const u32x2v*)(add + i); r0 += __uint_as_float(aw.x << 16); r1 += __uint_as_float(aw.x & 0xFFFF0000u); r2 += __uint_as_float(aw.y << 16); r3 += __uint_as_float(aw.y & 0xFFFF0000u); }
        u32x2v w; w.x = pk2bf(r0, r1); w.y = pk2bf(r2, r3); *(u32x2v*)(o + i) = w; }
    __device__ __forceinline__ void store8(int row, int col, f32x4 v0, f32x4 v1) const { const size_t i = (size_t)row * D + col; const uint4 gq = *(const uint4*)(g + i);
        float r[8] = {__uint_as_float(gq.x << 16) * v0[0], __uint_as_float(gq.x & 0xFFFF0000u) * v0[1], __uint_as_float(gq.y << 16) * v0[2], __uint_as_float(gq.y & 0xFFFF0000u) * v0[3],
                      __uint_as_float(gq.z << 16) * v1[0], __uint_as_float(gq.z & 0xFFFF0000u) * v1[1], __uint_as_float(gq.w << 16) * v1[2], __uint_as_float(gq.w & 0xFFFF0000u) * v1[3]};
        if (add) { const uint4 aq = *(const uint4*)(add + i); r[0] += __uint_as_float(aq.x << 16); r[1] += __uint_as_float(aq.x & 0xFFFF0000u); r[2] += __uint_as_float(aq.y << 16); r[3] += __uint_as_float(aq.y & 0xFFFF0000u);
            r[4] += __uint_as_float(aq.z << 16); r[5] += __uint_as_float(aq.z & 0xFFFF0000u); r[6] += __uint_as_float(aq.w << 16); r[7] += __uint_as_float(aq.w & 0xFFFF0000u); }
        uint4 w; w.x = pk2bf(r[0], r[1]); w.y = pk2bf(r[2], r[3]); w.z = pk2bf(r[4], r[5]); w.w = pk2bf(r[6], r[7]); *(uint4*)(o + i) = w; } };
struct EResid { float* x; __device__ __forceinline__ void store4(int row, int col, f32x4 v) const { f32x4* q = (f32x4*)(x + (size_t)row * D + col); *q = *q + v; } };
struct EScoreT { float* s; __device__ __forceinline__ void store4(int row  , int col  , f32x4 v) const {
#pragma unroll
        for (int i = 0; i < 4; ++i) s[(size_t)(col + i) * MT + row] = v[i]; }
    __device__ __forceinline__ void storeN(int n, int tok, f32x4 v) const { *(f32x4*)(s + (size_t)n * MT + tok) = v; } };

template <class F> struct EpiAdapt { static constexpr bool PERM = false, AFTER_DRAIN = false; F f;
    __device__ __forceinline__ void operator()(const f32x4 (&acc)[2][2][4][2], const pg8::Unit& u, int wr, int wc, int fr, int fq) const {
        const int row0 = u.pm * 256 + wr * 64 + fr, col0 = u.pn * 256 + wc * 32 + 4 * fq;
#pragma unroll
        for (int ai = 0; ai < 2; ++ai)
#pragma unroll
            for (int m = 0; m < 4; ++m)
#pragma unroll
                for (int bj = 0; bj < 2; ++bj)
#pragma unroll
                    for (int n = 0; n < 2; ++n) f.store4(row0 + ai * 128 + m * 16, col0 + bj * 128 + n * 16, acc[ai][bj][m][n]);
    } };

template <class F> __device__ __forceinline__ void small_gemm(const Ctx& c, const bf16_t* A, const bf16_t* Bt, int N, int K, const F& f) {
    const int ntasks = (N / 16) * 8, lane = c.lane;
    for (int task = c.gwave; task < ntasks; task += c.nwaves) {
        const int tn = task >> 3, tm = task & 7;
        const bf16_t* ap = A + (size_t)(MP + tm * 16 + (lane & 15)) * K + (lane >> 4) * 8; const bf16_t* bp = Bt + (size_t)(tn * 16 + (lane & 15)) * K + (lane >> 4) * 8;
        f32x4 acc = {0.f, 0.f, 0.f, 0.f};
#pragma unroll 1
        for (int k = 0; k < K; k += 512) { bf16x8 a[16], b[16];
#pragma unroll
            for (int i = 0; i < 16; ++i) { a[i] = *(const bf16x8*)(ap + k + 32 * i); b[i] = *(const bf16x8*)(bp + k + 32 * i); }
            asm volatile("" ::: "memory");
#pragma unroll
            for (int i = 0; i < 16; ++i) acc = __builtin_amdgcn_mfma_f32_16x16x32_bf16(b[i], a[i], acc, 0, 0, 0); }
        f.store4(MP + tm * 16 + (lane & 15), tn * 16 + (lane >> 4) * 4, acc);
    }
}
template <class F> struct EpiAdaptT { static constexpr bool PERM = false, AFTER_DRAIN = false; F f;
    __device__ __forceinline__ void operator()(const f32x4 (&acc)[2][2][4][2], const pg8::Unit& u, int wr, int wc, int fr, int fq) const {
        const int row0 = u.pm * 256 + wr * 64 + fr, col0 = u.pn * 256 + wc * 32 + 4 * fq;
#pragma unroll
        for (int ai = 0; ai < 2; ++ai)
#pragma unroll
            for (int mm = 0; mm < 4; ++mm)
#pragma unroll
                for (int bj = 0; bj < 2; ++bj)
#pragma unroll
                    for (int n = 0; n < 2; ++n) f.storeN(row0 + ai * 128 + mm * 16, col0 + bj * 128 + n * 16, acc[ai][bj][mm][n]);
    } };
struct OneUnit { int pm, pn; bool has;
    __device__ __forceinline__ bool next(int i, pg8::Unit& u) const { if (i != 0 || !has) return false; u.pm = pm; u.pn = pn; return true; }
    __device__ __forceinline__ void a_ready(const pg8::Unit&) const {}
    __device__ __forceinline__ void done(const pg8::Unit&) const {} };
#define SEL_RD(k_) L[(k_) * 256 + (t ^ (((k_) & 15) << 2))]
#define SEL_STAGE_A(side_) do { unsigned top[16]; \
    _Pragma("unroll") for (int kh = 0; kh < 128; kh += 64) { float v[64]; \
        _Pragma("unroll") for (int k = 0; k < 64; ++k) v[k] = SEL_RD(kh + k); \
        _Pragma("unroll") for (int g = 0; g < 4; ++g) { unsigned s[16]; \
            _Pragma("unroll") for (int i = 0; i < 16; ++i) s[i] = (fkey(v[g * 16 + i]) & ~127u) | (unsigned)(127 - kh - g * 16 - i); \
            if (kh == 0 && g == 0) { bitonic_sort16<true>(s); _Pragma("unroll") for (int i = 0; i < 16; ++i) top[i] = s[i]; } \
            else { bitonic_sort16<false>(s); _Pragma("unroll") for (int i = 0; i < 16; ++i) top[i] = __builtin_elementwise_max(top[i], s[i]); bitonic_merge16_desc(top); } } } \
    _Pragma("unroll") for (int i = 0; i < 16; ++i) { const int k = 127 - (int)(top[i] & 127u); ti[side_][i] = k; tv[side_][i] = SEL_RD(k); } } while (0)
struct EpiSel { static constexpr bool PERM = false, AFTER_DRAIN = true; unsigned char* ws; int tile;
    __device__ __forceinline__ void fused(const f32x4 (&acc)[2][2][4][2], const pg8::Unit& u, int wr, int wc, int fr, int fq, PG8_LAS unsigned char* ldsb, int wid, int lane) const {
        float* L = (float*)ldsb; const int t = wid * 64 + lane;
#pragma unroll
        for (int mm = 0; mm < 4; ++mm)
#pragma unroll
            for (int bj = 0; bj < 2; ++bj)
#pragma unroll
                for (int n = 0; n < 2; ++n) { const int k = 64 * wr + 16 * mm + fr, col = 128 * bj + 32 * wc + 16 * n + 4 * fq;
                    *(f32x4*)(L + k * 256 + (col ^ ((k & 15) << 2))) = acc[0][bj][mm][n]; }
        __syncthreads();
        float tv[2][16]; int ti[2][16];
        if (t < 256) SEL_STAGE_A(0);
        __syncthreads();
#pragma unroll
        for (int mm = 0; mm < 4; ++mm)
#pragma unroll
            for (int bj = 0; bj < 2; ++bj)
#pragma unroll
                for (int n = 0; n < 2; ++n) { const int k = 64 * wr + 16 * mm + fr, col = 128 * bj + 32 * wc + 16 * n + 4 * fq;
                    *(f32x4*)(L + k * 256 + (col ^ ((k & 15) << 2))) = acc[1][bj][mm][n]; }
        __syncthreads();
        if (t < 256) SEL_STAGE_A(1);
        __syncthreads();
        if (t < 256) {
            float* tvl = L + t; int* til = (int*)L + 32 * 256 + t;
#pragma unroll
            for (int sd = 0; sd < 2; ++sd)
#pragma unroll
                for (int i = 0; i < 16; ++i) { tvl[(sd * 16 + i) * 256] = tv[sd][i]; til[(sd * 16 + i) * 256] = ti[sd][i]; }
            unsigned top[16];
#pragma unroll
            for (int g = 0; g < 4; ++g) {
                unsigned s[16];
#pragma unroll
                for (int i = 0; i < 16; ++i) s[i] = 0u;
                { int cnt = 0;
#pragma unroll
                  for (int a = 0; a < 16; ++a)
#pragma unroll
                    for (int b = 0; b < 16; ++b) if ((a + 1) * (b + 1) <= 16) { if (cnt / 16 == g) s[cnt % 16] = (fkey(tv[0][a] + tv[1][b]) & ~255u) | (unsigned)(255 - (a * 16 + b)); ++cnt; } }
                if (g == 0) { bitonic_sort16<true>(s);
#pragma unroll
                    for (int i = 0; i < 16; ++i) top[i] = s[i]; }
                else { bitonic_sort16<false>(s);
#pragma unroll
                    for (int i = 0; i < 16; ++i) top[i] = __builtin_elementwise_max(top[i], s[i]);
                    bitonic_merge16_desc(top); }
            }
            float cv[16]; int ce[16];
#pragma unroll
            for (int i = 0; i < 16; ++i) { const int cc = 255 - (int)(top[i] & 255u), a = cc >> 4, b = cc & 15; cv[i] = tvl[a * 256] + tvl[(16 + b) * 256]; ce[i] = til[a * 256] * 128 + til[(16 + b) * 256]; }
            float mx = cv[0];
#pragma unroll
            for (int i = 1; i < 16; ++i) mx = fmaxf(mx, cv[i]);
            float ev[16], sm = 0.f;
#pragma unroll
            for (int i = 0; i < 16; ++i) { ev[i] = __expf(cv[i] - mx); sm += ev[i]; }
            const float inv = 1.f / sm; const size_t tok = (size_t)u.pn * 256 + t;
            int* eo = (int*)(ws + WS_EID) + tok * 128 + u.pm * 16; float* go = (float*)(ws + WS_GW) + tok * 128 + u.pm * 16;
#pragma unroll
            for (int j = 0; j < 4; ++j) { *(int4*)(eo + 4 * j) = make_int4(ce[4 * j], ce[4 * j + 1], ce[4 * j + 2], ce[4 * j + 3]);
                *(float4*)(go + 4 * j) = make_float4(ev[4 * j] * inv, ev[4 * j + 1] * inv, ev[4 * j + 2] * inv, ev[4 * j + 3] * inv); }
        }
        __syncthreads();
    } };
#undef SEL_RD
#undef SEL_STAGE_A
template <class F> __device__ __forceinline__ void gemm_scores_select(const Ctx& c, unsigned char* ws, const bf16_t* H, const bf16_t* Wpk, const F& fsample) {
    pg8::Gemm g{Wpk, H, 2048, MP, D};
    { const int U = c.bid; OneUnit S{U & 7, U >> 3, U < 256}; EpiSel E{ws, U & 255}; pg8::gemm_phase<EpiSel, OneUnit, false>((PG8_LAS unsigned char*)c.lds, g, S, E, nullptr); }
    { const int U = 256 + c.bid; OneUnit S{U & 7, U >> 3, U < 512}; EpiSel E{ws, 256 + (c.bid & 255)}; pg8::gemm_phase<EpiSel, OneUnit, false>((PG8_LAS unsigned char*)c.lds, g, S, E, nullptr); }
    small_gemm(c, H, Wpk, 2048, D, fsample);
}
template <class F> struct EpiAdaptP { static constexpr bool PERM = true, AFTER_DRAIN = false; F f;
    __device__ __forceinline__ void operator()(const f32x4 (&acc)[2][2][4][2], const pg8::Unit& u, int wr, int wc, int fr, int fq) const {
        const int row0 = u.pm * 256 + wr * 64 + fr, col0 = u.pn * 256 + wc * 32 + 8 * fq;
#pragma unroll
        for (int ai = 0; ai < 2; ++ai)
#pragma unroll
            for (int mm = 0; mm < 4; ++mm)
#pragma unroll
                for (int bj = 0; bj < 2; ++bj) f.store8(row0 + ai * 128 + mm * 16, col0 + bj * 128, acc[ai][bj][mm][0], acc[ai][bj][mm][1]);
    } };
template <class F> __device__ __forceinline__ void gemm_both8(const Ctx& c, const bf16_t* A, const bf16_t* Bt, int N, int K, const F& f) {
    pg8::Gemm g{A, Bt, MP, N, K}; pg8::StaticOrder S; S.init(MP, N, c.G, c.bid); EpiAdaptP<F> E{f};
    pg8::gemm_phase<EpiAdaptP<F>, pg8::StaticOrder, false>((PG8_LAS unsigned char*)c.lds, g, S, E, nullptr);
    small_gemm(c, A, Bt, N, K, f);
}
template <class F> __device__ __forceinline__ void gemm_both(const Ctx& c, const bf16_t* A, const bf16_t* Bt, int N, int K, const F& f) {
    pg8::Gemm g{A, Bt, MP, N, K}; pg8::StaticOrder S; S.init(MP, N, c.G, c.bid); EpiAdapt<F> E{f};
    pg8::gemm_phase<EpiAdapt<F>, pg8::StaticOrder, false>((PG8_LAS unsigned char*)c.lds, g, S, E, nullptr);
    small_gemm(c, A, Bt, N, K, f);
}

constexpr int NPH = 12;
constexpr int NSTEPS = 1 + DEPTH * NPH;
constexpr int LDS_STAGE = 131072, LDS_BYTES = LDS_STAGE + 256;

template <int layer> __device__ __forceinline__ void layer_steps(const int lo, const int hi, const XcdBarrier& bar, unsigned char* shm) {
#define KP kargs()
#ifndef PHMASK
#define PHMASK 0xFFFF
#endif
#define IN(k) (lo <= (k) && (k) < hi)
#define ON(b) ((PHMASK >> (b)) & 1)
#ifndef BARX
#define BARX 1
#endif
#define SEAM(k) do { if (IN(k) && IN((k) + 1)) { for (int bx_ = 0; bx_ < BARX; ++bx_) xcd_barrier(bar); } } while (0)
#ifndef REPPH
#define REPPH -1
#define REPN 1
#endif
#define REPEAT(k) for (int rep_ = 0; rep_ < ((REPPH) == (k) ? (REPN) : 1); ++rep_)
        const int s0 = 1 + layer * NPH;
        if (ON(0) && IN(s0 + 0)) REPEAT(0) { phase_rms(KP, mkctx(shm), KP->norm1 + layer * D, layer == 0); }
        SEAM(s0 + 0);
        if (ON(1) && IN(s0 + 1)) REPEAT(1) { gemm_both8(mkctx(shm), (const bf16_t*)(KP->ws + WS_H), (const bf16_t*)(KP->ws + WS_WIN) + (size_t)layer * NINP * D, NINP, D, EPraw{KP->ws, KP->out, layer}); }
        SEAM(s0 + 1);
        if (ON(2) && IN(s0 + 2)) REPEAT(2) { phase_post(KP, mkctx(shm), layer); }
        SEAM(s0 + 2);
        if (ON(3) && IN(s0 + 3)) { REPEAT(13) { phase_sb_mfma(KP, mkctx(shm), layer); } __syncthreads(); REPEAT(3) { phase_dsa_select(KP, mkctx(shm), layer, rep_); } }
        SEAM(s0 + 3);
        if (ON(4) && IN(s0 + 4)) REPEAT(4) { phase_dsa_attn(KP, mkctx(shm), layer, rep_); }
        SEAM(s0 + 4);
        if (ON(5) && IN(s0 + 5)) REPEAT(5) { gemm_both8(mkctx(shm), (const bf16_t*)(KP->ws + WS_OA), (const bf16_t*)(KP->ws + WS_WPA) + (size_t)layer * D * 512, D, 512, EGate{(bf16_t*)(KP->ws + WS_T), (const bf16_t*)(KP->ws + WS_SGA), nullptr});
            asm volatile("s_waitcnt vmcnt(0)" ::: "memory"); __syncthreads();
            gemm_both8(mkctx(shm), (const bf16_t*)(KP->ws + WS_OB), (const bf16_t*)(KP->ws + WS_WPB) + (size_t)layer * D * 512, D, 512, EGate{(bf16_t*)(KP->ws + WS_M), (const bf16_t*)(KP->ws + WS_SGB), (const bf16_t*)(KP->ws + WS_T)}); }
        SEAM(s0 + 5);
        if (ON(7) && IN(s0 + 6)) REPEAT(7) { gemm_both(mkctx(shm), (const bf16_t*)(KP->ws + WS_M), (const bf16_t*)(KP->ws + WS_WO) + (size_t)layer * D * D, D, D, EResid{KP->out}); }
        SEAM(s0 + 6);
        if (ON(8) && IN(s0 + 7)) REPEAT(8) { phase_rms(KP, mkctx(shm), KP->norm2 + layer * D, false); }
        SEAM(s0 + 7);
        if (ON(9) && IN(s0 + 8)) REPEAT(9) { gemm_scores_select(mkctx(shm), KP->ws, (const bf16_t*)(KP->ws + WS_H), (const bf16_t*)(KP->ws + WS_WPK) + (size_t)layer * 2048 * D, EScoreT{(float*)(KP->ws + WS_PRAW)}); }
        SEAM(s0 + 8);
        if (ON(10) && IN(s0 + 9)) REPEAT(10) { phase_peer_select(KP, mkctx(shm)); }
        SEAM(s0 + 9);
        if (ON(11) && IN(s0 + 10)) REPEAT(11) { phase_peer_u(KP, mkctx(shm), layer, rep_); }
        SEAM(s0 + 10);
        if (ON(13) && IN(s0 + 11)) REPEAT(12) { phase_peer_v(KP, mkctx(shm), layer, rep_); }
        SEAM(s0 + 11);
#undef KP
#undef IN
#undef ON
#undef SEAM
#undef REPEAT
}

__global__ void __launch_bounds__(512, 2) k_fwd(const Params p_unused) {
    extern __shared__ __attribute__((aligned(16))) unsigned char shm[];
    volatile LAS unsigned* xbw = (volatile LAS unsigned*)(shm + LDS_STAGE);
    if (threadIdx.x < 4) xbw[threadIdx.x] = 0u;
    __syncthreads();
#define KP kargs()
    const int lo = KP->ph_lo, hi = KP->ph_hi;
    XcdBarrier bar; bar.bar = (unsigned*)(KP->ws + WS_BAR); bar.x = 0; bar.st = xbw;
    if (hi - lo > 1) bar = xcd_barrier_post((unsigned*)(KP->ws + WS_BAR), xbw);
#ifndef PHMASK
#define PHMASK 0xFFFF
#endif
#define IN(k) (lo <= (k) && (k) < hi)
#define ON(b) ((PHMASK >> (b)) & 1)
#ifndef BARX
#define BARX 1
#endif
#define SEAM(k) do { if (IN(k) && IN((k) + 1)) { for (int bx_ = 0; bx_ < BARX; ++bx_) xcd_barrier(bar); } } while (0)
#ifndef REPPH
#define REPPH -1
#define REPN 1
#endif
    if (ON(12) && IN(0)) for (int rep_ = 0; rep_ < ((REPPH) == 20 ? (REPN) : 1); ++rep_) { phase_prologue(KP, mkctx(shm)); }
    SEAM(0);
    layer_steps<0>(lo, hi, bar, shm); layer_steps<1>(lo, hi, bar, shm); layer_steps<2>(lo, hi, bar, shm); layer_steps<3>(lo, hi, bar, shm);
#undef IN
#undef KP
#undef SEAM
}
}

#ifndef MK_ONE_LAUNCH
#define MK_ONE_LAUNCH 1
#endif

extern "C" void kernel_launch(void* const* d_in, const int* in_sizes, int n_in, void* d_out, int out_size, void* d_ws, size_t ws_size, hipStream_t stream) {
    using namespace mk;
    static int grid = 0;
    if (grid == 0) {
        if (n_in != 21 || (size_t)out_size != O_END || ws_size < WS_END) { fprintf(stderr, "kernel_launch: unexpected sizes: n_in %d out %d (want %zu) ws %zu (want %zu)\n", n_in, out_size, O_END, ws_size, WS_END); grid = -1; return; }
        if (hipFuncSetAttribute((const void*)k_fwd, hipFuncAttributeMaxDynamicSharedMemorySize, LDS_BYTES) != hipSuccess) { fprintf(stderr, "kernel_launch: hipFuncSetAttribute failed\n"); grid = -1; return; }
        int dev = 0, cus = 0, per_cu = 0;
        if (hipGetDevice(&dev) != hipSuccess || hipDeviceGetAttribute(&cus, hipDeviceAttributeMultiprocessorCount, dev) != hipSuccess) { grid = -1; return; }
        if (hipOccupancyMaxActiveBlocksPerMultiprocessor(&per_cu, (const void*)k_fwd, 512, LDS_BYTES) != hipSuccess || per_cu < 1) { fprintf(stderr, "kernel_launch: occupancy query says %d\n", per_cu); (void)hipGetLastError(); }
        grid = cus;
        if (grid != 256) { fprintf(stderr, "kernel_launch: built for a 256-CU device (two score-GEMM units per workgroup); this device reports %d CUs: nothing launched\n", cus); grid = -1; return; }
    }
    if (grid < 0) return;
    (void)hipMemsetAsync((char*)d_ws + WS_BAR, 0, WS_ZERO_BYTES, stream);
    Params p{};
    const float** pp = (const float**)&p;
    for (int i = 0; i < 21; ++i) pp[i] = (const float*)d_in[i];
    p.out = (float*)d_out; p.ws = (unsigned char*)d_ws;
#if MK_ONE_LAUNCH
    p.ph_lo = 0; p.ph_hi = NSTEPS;
    hipLaunchKernelGGL(k_fwd, dim3(grid), dim3(512), LDS_BYTES, stream, p);
#else
    for (int s = 0; s < NSTEPS; ++s) { p.ph_lo = s; p.ph_hi = s + 1; hipLaunchKernelGGL(k_fwd, dim3(grid), dim3(512), LDS_BYTES, stream, p); }
#endif
}
```

```cpp
#include <hip/hip_runtime.h>
#include <cstdio>
#include <cstdint>
namespace pg8 {
#define PG8_LAS __attribute__((address_space(3)))
typedef unsigned short bf16_t;
typedef short bf16x8 __attribute__((ext_vector_type(8)));
typedef float f32x4 __attribute__((ext_vector_type(4)));
typedef unsigned u32x4 __attribute__((ext_vector_type(4)));
constexpr int BM = 256, BK = 64, HALF = 128, HTB = HALF * BK * 2  , STAGE_BYTES = 8 * HTB, NXCD = 8, WGM = 8;

__host__ __device__ __forceinline__ int lds_byte(int r, int c) { const int st = (r >> 4) * 2 + (c >> 5), rr = r & 15, cc = c & 31, ob = rr * 64 + cc * 2; return st * 1024 + (ob ^ (((ob >> 9) & 1) << 5)); }
__host__ __device__ __forceinline__ void stage_rc(int b, int& R, int& C) { const int st = b / 1024, sb = b % 1024, swz = sb ^ (((sb >> 9) & 1) << 5); R = (st >> 1) * 16 + swz / 64; C = (st & 1) * 32 + (swz % 64) / 2; }
__host__ __device__ __forceinline__ int perm32(int rho) { const int n = rho >> 4, i = rho & 15; return 8 * (i >> 2) + 4 * n + (i & 3); }

struct Unit { int pm, pn; };
struct Gemm { const bf16_t* A; const bf16_t* Bt; int M, N, K; };

struct StaticOrder {
    int nM, nN, nwg, G, c;
    __host__ __device__ void init(int M, int N, int G_, int c_) { nM = M / BM; nN = N / BM; nwg = nM * nN; G = G_; c = c_; }
    __host__ __device__ bool next(int i, Unit& u) const {
        const long L = (long)i * G + c; if (L >= nwg) return false;
        int wgid = (int)L; { const int q = nwg / NXCD, r = nwg % NXCD, xcd = wgid % NXCD, off = wgid / NXCD; wgid = (xcd < r ? xcd * (q + 1) : r * (q + 1) + (xcd - r) * q) + off; }
        const int nig = WGM * nN, gid = wgid / nig, fm = gid * WGM, gsz = (nM - fm) < WGM ? (nM - fm) : WGM;
        u.pm = fm + ((wgid % nig) % gsz); u.pn = (wgid % nig) / gsz; return true;
    }
    __device__ __forceinline__ void a_ready(const Unit&) const {}
    __device__ __forceinline__ void done(const Unit&) const {}
};
__device__ __forceinline__ unsigned cvt_pk_bf16(float lo, float hi) { unsigned r; asm volatile("v_cvt_pk_bf16_f32 %0, %1, %2" : "=v"(r) : "v"(lo), "v"(hi)); return r; }
template <class Epi, class Sched, bool STAMP = false>
__device__ __forceinline__ void gemm_phase(PG8_LAS unsigned char* lds, const Gemm g, const Sched& S, const Epi& E, unsigned long long* stamps) {
    int tid_l = threadIdx.x; asm volatile("" : "+v"(tid_l));
    const int tid = tid_l, wid = __builtin_amdgcn_readfirstlane(tid >> 6), lane = tid & 63, wr = wid >> 2, wc = wid & 3, fr = lane & 15, fq = lane >> 4;
    const int K = g.K, nt = K / BK;
    int ts_lo = 0, ts_hi = 0, nts = 0; const unsigned long long rt_entry = STAMP ? (unsigned long long)wall_clock64() : 0ull;
#define PG8_STAMP() do { if (STAMP && wid == 0 && nts < 64) { const unsigned long long _c = (unsigned long long)clock64(); \
        ts_lo = (lane == nts) ? (int)(unsigned)_c : ts_lo; ts_hi = (lane == nts) ? (int)(unsigned)(_c >> 32) : ts_hi; ++nts; } } while (0)
    PG8_STAMP();
    unsigned voffA[2], voffB[2];
#pragma unroll
    for (int i = 0; i < 2; ++i) { int R, C; stage_rc(tid * 16 + i * 8192, R, C); const int Rb = Epi::PERM ? ((R & ~31) + perm32(R & 31)) : R;
        voffA[i] = (unsigned)(R * K + C) * 2u; voffB[i] = (unsigned)(Rb * K + C) * 2u; }
    const size_t kstep = (size_t)(BK * 2);
    const size_t hstep = (size_t)HALF * K * 2;
    const size_t tstep = 2 * hstep;
    const unsigned ldsw = (unsigned)wid * 1024u;
    const int aoff = lds_byte(wr * 64 + fr, fq * 8), boff = lds_byte(wc * 32 + fr, fq * 8);
#define PG8_SA(b, h) (((b) * 2 + (h)) * HTB)
#define PG8_SB(b, h) ((4 + (b) * 2 + (h)) * HTB)
#define PG8_STAGE(bufoff, gbase, voff) do { _Pragma("unroll") for (int _i = 0; _i < 2; ++_i) \
        __builtin_amdgcn_global_load_lds((const unsigned*)((const char*)(gbase) + (voff)[_i]), (PG8_LAS unsigned*)(lds + (bufoff) + ldsw + _i * 8192), 16, 0, 0); } while (0)
#define PG8_LDA(dst, b, h) do { _Pragma("unroll") for (int m = 0; m < 4; ++m) _Pragma("unroll") for (int k = 0; k < 2; ++k) dst[m][k] = *(const PG8_LAS bf16x8*)(lds + PG8_SA(b, h) + aoff + m * 2048 + k * 1024); } while (0)
#define PG8_LDB(dst, b, h) do { _Pragma("unroll") for (int n = 0; n < 2; ++n) _Pragma("unroll") for (int k = 0; k < 2; ++k) dst[n][k] = *(const PG8_LAS bf16x8*)(lds + PG8_SB(b, h) + boff + n * 2048 + k * 1024); } while (0)
#define PG8_MMA(ai, bj, At, Bt) do { __builtin_amdgcn_s_setprio(1); _Pragma("unroll") for (int m = 0; m < 4; ++m) _Pragma("unroll") for (int n = 0; n < 2; ++n) _Pragma("unroll") for (int k = 0; k < 2; ++k) \
        acc[ai][bj][m][n] = __builtin_amdgcn_mfma_f32_16x16x32_bf16(Bt[n][k], At[m][k], acc[ai][bj][m][n], 0, 0, 0); __builtin_amdgcn_s_setprio(0); } while (0)
#define PG8_WAIT_V(n) asm volatile("s_waitcnt vmcnt(" #n ")" ::: "memory")
#define PG8_WAIT_L(n) asm volatile("s_waitcnt lgkmcnt(" #n ")" ::: "memory")
#define PG8_BAR __builtin_amdgcn_s_barrier()
#define PG8_SCHED __builtin_amdgcn_sched_barrier(0)
    Unit cur, nxt; int ui = 0;
    if (!S.next(0, cur)) return;
    f32x4 acc[2][2][4][2];
#pragma unroll
    for (int a = 0; a < 2; ++a)
#pragma unroll
        for (int b = 0; b < 2; ++b)
#pragma unroll
            for (int m = 0; m < 4; ++m)
#pragma unroll
                for (int n = 0; n < 2; ++n) acc[a][b][m][n] = (f32x4){0.f, 0.f, 0.f, 0.f};
    bf16x8 At[4][2], B0[2][2], B1[2][2];
    const char* cA = (const char*)g.A + (size_t)cur.pm * tstep; const char* cB = (const char*)g.Bt + (size_t)cur.pn * tstep;
    S.a_ready(cur);
    PG8_STAGE(PG8_SB(0, 0), cB, voffB); PG8_STAGE(PG8_SA(0, 0), cA, voffA); PG8_STAGE(PG8_SB(0, 1), cB + hstep, voffB); PG8_STAGE(PG8_SA(0, 1), cA + hstep, voffA);
    if (wr == 1) PG8_BAR;
    PG8_WAIT_V(4); PG8_BAR;
    PG8_STAGE(PG8_SB(1, 0), cB + kstep, voffB); PG8_STAGE(PG8_SA(1, 0), cA + kstep, voffA); PG8_STAGE(PG8_SB(1, 1), cB + hstep + kstep, voffB);
    PG8_WAIT_V(6); PG8_BAR;
    PG8_STAMP();
    for (;;) {
        const bool has_next = S.next(ui + 1, nxt);
        const char* nA = has_next ? (const char*)g.A + (size_t)nxt.pm * tstep : cA; const char* nB = has_next ? (const char*)g.Bt + (size_t)nxt.pn * tstep : cB;
        for (int t = 0; t < nt; t += 2) {
            const bool last = (t == nt - 2);
            const char* a1 = cA + (size_t)(t + 1) * kstep;
            const char* a2 = last ? nA : cA + (size_t)(t + 2) * kstep; const char* b2 = last ? nB : cB + (size_t)(t + 2) * kstep;
            const char* a3 = a2 + kstep; const char* b3 = b2 + kstep;
            if (last && has_next) S.a_ready(nxt);
            PG8_LDB(B0, 0, 0); PG8_SCHED; PG8_LDA(At, 0, 0); PG8_STAGE(PG8_SA(1, 1), a1 + hstep, voffA);
            PG8_WAIT_L(8); PG8_BAR; PG8_WAIT_L(0); PG8_MMA(0, 0, At, B0); PG8_BAR; PG8_SCHED;
            PG8_LDB(B1, 0, 1); PG8_STAGE(PG8_SB(0, 0), b2, voffB);
            PG8_BAR; PG8_WAIT_L(0); PG8_MMA(0, 1, At, B1); PG8_BAR;
            PG8_LDA(At, 0, 1); PG8_STAGE(PG8_SA(0, 0), a2, voffA);
            PG8_BAR; PG8_WAIT_L(0); PG8_MMA(1, 0, At, B0); PG8_BAR; PG8_SCHED;
            PG8_STAGE(PG8_SB(0, 1), b2 + hstep, voffB);
            PG8_WAIT_V(6); PG8_BAR; PG8_MMA(1, 1, At, B1); PG8_BAR;
            PG8_LDB(B0, 1, 0); PG8_SCHED; PG8_LDA(At, 1, 0); PG8_STAGE(PG8_SA(0, 1), a2 + hstep, voffA);
            PG8_WAIT_L(8); PG8_BAR; PG8_WAIT_L(0); PG8_MMA(0, 0, At, B0); PG8_BAR; PG8_SCHED;
            PG8_LDB(B1, 1, 1); PG8_STAGE(PG8_SB(1, 0), b3, voffB);
            PG8_BAR; PG8_WAIT_L(0); PG8_MMA(0, 1, At, B1); PG8_BAR;
            PG8_LDA(At, 1, 1); PG8_STAGE(PG8_SA(1, 0), a3, voffA);
            PG8_BAR; PG8_WAIT_L(0); PG8_MMA(1, 0, At, B0); PG8_BAR; PG8_SCHED;
            PG8_STAGE(PG8_SB(1, 1), b3 + hstep, voffB);
            PG8_WAIT_V(6); PG8_BAR; PG8_MMA(1, 1, At, B1); PG8_BAR;
        }
        PG8_STAMP();
        if constexpr (!Epi::AFTER_DRAIN) { E(acc, cur, wr, wc, fr, fq); S.done(cur); }
        PG8_STAMP();
        if (!has_next) break;
#pragma unroll
        for (int a = 0; a < 2; ++a)
#pragma unroll
            for (int b = 0; b < 2; ++b)
#pragma unroll
                for (int m = 0; m < 4; ++m)
#pragma unroll
                    for (int n = 0; n < 2; ++n) acc[a][b][m][n] = (f32x4){0.f, 0.f, 0.f, 0.f};
        cur = nxt; cA = nA; cB = nB; ++ui;
    }
    PG8_WAIT_V(0);
    if (wr == 0) PG8_BAR;
    PG8_BAR;
    if constexpr (Epi::AFTER_DRAIN) { E.fused(acc, cur, wr, wc, fr, fq, lds, wid, lane); S.done(cur); }
    PG8_STAMP();
    if (STAMP && wid == 0) { stamps[lane] = lane < nts ? (((unsigned long long)(unsigned)ts_hi << 32) | (unsigned)ts_lo) : 0ull;
        if (lane == 62) stamps[62] = rt_entry; if (lane == 63) stamps[63] = (unsigned long long)wall_clock64(); }
#undef PG8_STAMP
#undef PG8_SA
#undef PG8_SB
#undef PG8_STAGE
#undef PG8_LDA
#undef PG8_LDB
#undef PG8_MMA
#undef PG8_WAIT_V
#undef PG8_WAIT_L
#undef PG8_BAR
#undef PG8_SCHED
}
}
#define XB_TMO      128
#define XB_XCNT(j)  (256  + 64 * (j))
#define XB_XSUB(j)  (1280 + 64 * (j))
#define XB_XGEN(j)  (2304 + 64 * (j))
#define XB_TOP      3328
#define XB_TOPGEN   3392
#define XCD_BAR_WORDS 3456
#define XB_SPIN_CAP (1u << 18)
#define LAS __attribute__((address_space(3)))

__device__ __forceinline__ unsigned xb_ld(unsigned* p)              { return __hip_atomic_load(p, __ATOMIC_RELAXED, __HIP_MEMORY_SCOPE_AGENT); }
__device__ __forceinline__ unsigned xb_add(unsigned* p, unsigned v) { return __hip_atomic_fetch_add(p, v, __ATOMIC_RELAXED, __HIP_MEMORY_SCOPE_AGENT); }
__device__ __forceinline__ unsigned xb_xcc_id() { return (unsigned)__builtin_amdgcn_s_getreg((3 << 11) | 20) & 0xFu; }
#define XB_SPIN(cond, bar) do { unsigned _sp = 0; while (cond) { __builtin_amdgcn_s_sleep(1); \
    if ((++_sp & 255u) == 0u) { if (xb_ld(&(bar)[XB_TMO])) break; if (_sp > XB_SPIN_CAP) { atomicAdd(&(bar)[XB_TMO], 1u); break; } } } } while (0)

struct XcdBarrier {
    unsigned* bar; unsigned x;
    volatile LAS unsigned* st;
};

__device__ __forceinline__ XcdBarrier xcd_barrier_post(unsigned* bar, volatile LAS unsigned* st) {
    XcdBarrier b; b.bar = bar; b.x = xb_xcc_id(); b.st = st;
    if (threadIdx.x == 0) (void)xb_add(&bar[XB_XCNT(b.x)], 1u);
    return b;
}
__device__ __forceinline__ void xcd_barrier_complete(unsigned* bar, unsigned x, unsigned& nloc, unsigned& nx) {
    const unsigned G = gridDim.x * gridDim.y * gridDim.z;
    unsigned sum, cnt, mine, sp = 0u;
    for (;;) {
        sum = 0u; cnt = 0u; mine = 0u;
#pragma unroll
        for (unsigned j = 0; j < 16; ++j) { const unsigned c = xb_ld(&bar[XB_XCNT(j)]); sum += c; cnt += (c > 0u) ? 1u : 0u; mine = (j == x) ? c : mine; }
        if (sum == G) break;
        __builtin_amdgcn_s_sleep(1);
        if ((++sp & 255u) == 0u) { if (xb_ld(&bar[XB_TMO])) break; if (sp > XB_SPIN_CAP) { atomicAdd(&bar[XB_TMO], 1u); break; } }
    }
    nloc = mine > 0u ? mine : 1u; nx = cnt > 0u ? cnt : 1u;
}

__device__ __forceinline__ void xcd_barrier(const XcdBarrier& b) {
    asm volatile("s_waitcnt vmcnt(0)" ::: "memory");
    __syncthreads();
    if (threadIdx.x == 0) {
        unsigned* bar = b.bar;
        __builtin_amdgcn_s_waitcnt(0);
        unsigned nloc = b.st[0], nx = b.st[1];
        if (nloc == 0u) { xcd_barrier_complete(bar, b.x, nloc, nx); b.st[0] = nloc; b.st[1] = nx; }
        const unsigned old = xb_add(&bar[XB_XSUB(b.x)], 1u);
        const unsigned gen = old / nloc;
        if (old + 1u == (gen + 1u) * nloc) {
            __builtin_amdgcn_fence(__ATOMIC_RELEASE, "agent");
            asm volatile("s_waitcnt vmcnt(0)" ::: "memory");
            const unsigned og = xb_add(&bar[XB_TOP], 1u);
            const unsigned tg = og / nx;
            if (og + 1u == (tg + 1u) * nx) xb_add(&bar[XB_TOPGEN], 1u);
            else XB_SPIN(xb_ld(&bar[XB_TOPGEN]) == tg, bar);
            __builtin_amdgcn_fence(__ATOMIC_ACQUIRE, "agent");
            xb_add(&bar[XB_XGEN(b.x)], 1u);
            asm volatile("s_waitcnt vmcnt(0)" ::: "memory");
        } else {
            XB_SPIN(xb_ld(&bar[XB_XGEN(b.x)]) == gen, bar);
            __builtin_amdgcn_fence(__ATOMIC_ACQUIRE, "agent");
            asm volatile("s_waitcnt vmcnt(0)" ::: "memory");
        }
    }
    __syncthreads();
}

namespace mk {
using pg8::bf16_t; using pg8::bf16x8; using pg8::f32x4;
typedef unsigned u32x2v __attribute__((ext_vector_type(2)));
typedef float f32x16 __attribute__((ext_vector_type(16)));
typedef __bf16 bf16x2_t __attribute__((ext_vector_type(2)));
typedef float f32x2v __attribute__((ext_vector_type(2)));
typedef unsigned u32x4v __attribute__((ext_vector_type(4)));

constexpr int D = 1024, NB = 8, SEQ = 2048, DEPTH = 4, DSEQ = 16, PAST = 2048, SKEYS = PAST + DSEQ;
constexpr int MP = NB * SEQ, MS = NB * DSEQ, MT = MP + MS;
constexpr int NIN = 4936, NINP = 5120;
constexpr int C_QA = 0, C_KA = 512, C_VA = 640, C_QI = 768, C_KI = 1280, C_WI = 1344, C_QB = 1352, C_KB = 1864, C_VB = 2376, C_GA = 2888, C_GB = 3912;
constexpr int NEXP = 16384, TOPK = 256;
constexpr float EPS = 1e-6f;

constexpr size_t O_YP = 0, O_YS = O_YP + (size_t)MP * D, O_AKP = O_YS + (size_t)MS * D, O_AVP = O_AKP + (size_t)DEPTH * MP * 128,
                 O_IKP = O_AVP + (size_t)DEPTH * MP * 128, O_BKP = O_IKP + (size_t)DEPTH * MP * 64, O_BVP = O_BKP + (size_t)DEPTH * MP * 512,
                 O_AKS = O_BVP + (size_t)DEPTH * MP * 512, O_AVS = O_AKS + (size_t)DEPTH * MS * 128, O_IKS = O_AVS + (size_t)DEPTH * MS * 128,
                 O_BKS = O_IKS + (size_t)DEPTH * MS * 64, O_BVS = O_BKS + (size_t)DEPTH * MS * 512, O_END = O_BVS + (size_t)DEPTH * MS * 512;

constexpr size_t al(size_t x) { return (x + 255) & ~(size_t)255; }
constexpr size_t WS_BAR = 0;
constexpr size_t WS_CTR = 16384;
constexpr int CTR_PER_LAYER = 128;
constexpr size_t WS_ZERO_BYTES = 16384 + (size_t)DEPTH * CTR_PER_LAYER * 256;
constexpr size_t WS_ROPE = 163840;
constexpr size_t WS_WIN = WS_ROPE + al((size_t)SKEYS * 32 * 8);
constexpr size_t WS_WPA = WS_WIN + (size_t)DEPTH * NINP * D * 2;
constexpr size_t WS_WPB = WS_WPA + (size_t)DEPTH * D * 512 * 2;
constexpr size_t WS_WO  = WS_WPB + (size_t)DEPTH * D * 512 * 2;
constexpr size_t WS_WPK = WS_WO + (size_t)DEPTH * D * D * 2;
constexpr size_t WS_U8  = WS_WPK + (size_t)DEPTH * 2048 * D * 2;
constexpr size_t WS_V8  = WS_U8 + (size_t)DEPTH * NEXP * D;
constexpr size_t WS_SUI = WS_V8 + (size_t)DEPTH * NEXP * D;
constexpr size_t WS_SVI = WS_SUI + (size_t)DEPTH * NEXP * 4;
constexpr size_t WS_X8  = WS_SVI + (size_t)DEPTH * NEXP * 4;
constexpr size_t WS_KAS = WS_X8 + al((size_t)MT * D);
constexpr size_t WS_VAS = WS_KAS + al((size_t)DEPTH * NB * SKEYS * 128 * 2);
constexpr size_t WS_KIS = WS_VAS + al((size_t)DEPTH * NB * SKEYS * 128 * 2);
constexpr size_t WS_H   = WS_KIS + al((size_t)DEPTH * NB * SKEYS * 64 * 2);
constexpr size_t WS_PRAW = WS_H + al((size_t)MT * D * 2);
constexpr size_t WS_QA  = WS_PRAW + al((size_t)MT * NINP * 2);
constexpr size_t WS_QI  = WS_QA + al((size_t)MT * 512 * 2);
constexpr size_t WS_QB  = WS_QI + al((size_t)MT * 512 * 2);
constexpr size_t WS_WI  = WS_QB + al((size_t)MT * 512 * 2);
constexpr size_t WS_KAP = WS_WI + al((size_t)MT * 8 * 4);
constexpr size_t WS_VAP = WS_KAP + al((size_t)MP * 128 * 2);
constexpr size_t WS_KIP = WS_VAP + al((size_t)MP * 128 * 2);
constexpr size_t WS_KBP = WS_KIP + al((size_t)MP * 64 * 2);
constexpr size_t WS_VBP = WS_KBP + al((size_t)MP * 512 * 2);
constexpr size_t WS_KBN = WS_VBP + al((size_t)MP * 512 * 2);
constexpr size_t WS_VBN = WS_KBN + al((size_t)MS * 512 * 2);
constexpr size_t WS_SGA = WS_VBN + al((size_t)MS * 512 * 2);
constexpr size_t WS_SGB = WS_SGA + al((size_t)MT * D * 2);
constexpr size_t WS_OA  = WS_SGB + al((size_t)MT * D * 2);
constexpr size_t WS_OB  = WS_OA + al((size_t)MT * 512 * 2);
constexpr size_t WS_T   = WS_OB + al((size_t)MT * 512 * 2);
constexpr size_t WS_M   = WS_T + al((size_t)MT * D * 2);
constexpr size_t WS_EID = WS_M + al((size_t)MT * D * 2);
constexpr size_t WS_GW  = WS_EID + al((size_t)MT * 128 * 4);
constexpr size_t WS_VBT = WS_GW + al((size_t)MT * 128 * 4);
constexpr size_t WS_VAT = WS_VBT + al((size_t)NB * 8 * 64 * SEQ * 2);
constexpr int SKP = 2080;
constexpr size_t WS_VATS = WS_VAT + al((size_t)NB * 2 * 64 * SEQ * 2);
constexpr size_t WS_MASK = WS_VATS + al((size_t)DEPTH * NB * 2 * 64 * SKP * 2);
constexpr int SBT = 240, SBL = SBT + DSEQ;
constexpr size_t WS_KBS = WS_MASK + al((size_t)65 * MT * 4);
constexpr size_t WS_VBTS = WS_KBS + (size_t)DEPTH * NB * SBL * 512 * 2;
constexpr size_t WS_SCR = WS_VBTS + (size_t)DEPTH * NB * 8 * 64 * SBL * 2;
constexpr size_t WS_END = WS_SCR + (size_t)2 * 256 * 128 * 256 * 4;
static_assert((size_t)MT * 2048 * 4 <= (size_t)MT * NINP * 2, "scores alias");

struct Params {
    const float *x_prompt, *x_sample, *cache_a_k, *cache_a_v, *cache_idx_k, *cache_b_k, *cache_b_v;
    const float *norm1, *w_in, *qn, *kn, *ikn, *w_pa, *w_pb, *w_o, *norm2, *pwq, *pk1, *pk2, *pu, *pv;
    float* out; unsigned char* ws;
    int ph_lo, ph_hi;
};

__device__ __forceinline__ float bf2f(bf16_t v) { return __uint_as_float(((unsigned)v) << 16); }
__device__ __forceinline__ bf16_t f2bf(float f) { unsigned u = __float_as_uint(f); u += 0x7FFFu + ((u >> 16) & 1u); return (bf16_t)(u >> 16); }
__device__ __forceinline__ unsigned pk2bf(float lo, float hi) { return (unsigned)f2bf(lo) | ((unsigned)f2bf(hi) << 16); }
__device__ __forceinline__ float wsum(float v) { for (int o = 32; o; o >>= 1) v += __shfl_xor(v, o); return v; }
__device__ __forceinline__ float wmaxf(float v) { for (int o = 32; o; o >>= 1) v = fmaxf(v, __shfl_xor(v, o)); return v; }
__device__ __forceinline__ int wsumi(int v) { for (int o = 32; o; o >>= 1) v += __shfl_xor(v, o); return v; }
__device__ __forceinline__ int lane_prefix(unsigned long long m) { return (int)__builtin_amdgcn_mbcnt_hi((unsigned)(m >> 32), __builtin_amdgcn_mbcnt_lo((unsigned)m, 0u)); }
__device__ __forceinline__ float rdlane(float v, int j) { return __int_as_float(__builtin_amdgcn_readlane(__float_as_int(v), j)); }
#define WSYNC() do { asm volatile("s_waitcnt lgkmcnt(0)" ::: "memory"); __builtin_amdgcn_wave_barrier(); } while (0)
__device__ __forceinline__ unsigned fkey(float f) { const unsigned u = __float_as_uint(f); return (u & 0x80000000u) ? ~u : (u | 0x80000000u); }
__device__ __forceinline__ float softplusf(float z) { return fmaxf(z, 0.f) + log1pf(__expf(-fabsf(z))); }

#define AS4 __attribute__((address_space(4)))
typedef const AS4 Params* PP;
__device__ __forceinline__ PP kargs() { PP q = (PP)__builtin_amdgcn_kernarg_segment_ptr(); asm volatile("" : "+s"(q)); return q; }
#define UNPK8(q, f) do { const unsigned w_[4] = {(q).x, (q).y, (q).z, (q).w}; _Pragma("unroll") for (int e_ = 0; e_ < 8; ++e_) (f)[e_] = (e_ & 1) ? __uint_as_float(w_[e_ >> 1] & 0xFFFF0000u) : __uint_as_float(w_[e_ >> 1] << 16); } while (0)
struct Ctx { int tid, lane, wave, gwave, nwaves, bid, G; unsigned char* lds; };
__device__ __forceinline__ Ctx mkctx(unsigned char* shm) { Ctx c; int t = threadIdx.x; asm volatile("" : "+v"(t)); int b = blockIdx.x, g = gridDim.x; asm volatile("" : "+s"(b), "+s"(g));
    c.tid = t; c.lane = t & 63; c.wave = __builtin_amdgcn_readfirstlane(t >> 6); c.bid = b; c.G = g; c.gwave = b * 8 + c.wave; c.nwaves = g * 8; c.lds = shm; return c; }

__device__ __forceinline__ void transpose_tile(const Ctx& c, const float* src, int K, int N, bf16_t* dst, int k0, int n0) {
    float* t = (float*)c.lds;
    for (int i = c.tid; i < 4096; i += 512) { const int kk = i >> 6, nn = i & 63, n = n0 + nn; t[kk * 65 + nn] = (n < N) ? src[(size_t)(k0 + kk) * N + n] : 0.f; }
    __syncthreads();
    for (int i = c.tid; i < 4096; i += 512) { const int nn = i >> 6, kk = i & 63; dst[(size_t)(n0 + nn) * K + k0 + kk] = f2bf(t[kk * 65 + nn]); }
    __syncthreads();
}
__device__ __forceinline__ void phase_prologue(PP p, const Ctx& c) {
    const int G = c.G, bid = c.bid;
    {   constexpr int T_IN = (NINP / 64) * (D / 64), T_PA = (D / 64) * (512 / 64), T_O = (D / 64) * (D / 64), T_L = T_IN + 2 * T_PA + T_O;
        for (int t = bid; t < DEPTH * T_L; t += G) {
            const int l = t / T_L; int r = t % T_L;
            if (r < T_IN) { transpose_tile(c, p->w_in + (size_t)l * D * NIN, D, NIN, (bf16_t*)(p->ws + WS_WIN) + (size_t)l * NINP * D, (r % 16) * 64, (r / 16) * 64); continue; }
            r -= T_IN;
            if (r < T_PA) { transpose_tile(c, p->w_pa + (size_t)l * 512 * D, 512, D, (bf16_t*)(p->ws + WS_WPA) + (size_t)l * D * 512, (r % 8) * 64, (r / 8) * 64); continue; }
            r -= T_PA;
            if (r < T_PA) { transpose_tile(c, p->w_pb + (size_t)l * 512 * D, 512, D, (bf16_t*)(p->ws + WS_WPB) + (size_t)l * D * 512, (r % 8) * 64, (r / 8) * 64); continue; }
            r -= T_PA;
            transpose_tile(c, p->w_o + (size_t)l * D * D, D, D, (bf16_t*)(p->ws + WS_WO) + (size_t)l * D * D, (r % 16) * 64, (r / 16) * 64);
        }
    }
    {   float* Ks = (float*)c.lds; float* Ps = Ks + 128 * 65;
        for (int t = bid; t < DEPTH * 8 * 2 * 16; t += G) {
            const int kt = t & 15, j = (t >> 4) & 1, h = (t >> 5) & 7, l = t >> 8, k0 = kt * 64;
            const float* ksrc = (j ? p->pk2 : p->pk1) + ((size_t)(l * 8 + h) * 128) * 64;
            for (int i = c.tid; i < 8192; i += 512) Ks[(i >> 6) * 65 + (i & 63)] = ksrc[i];
            for (int i = c.tid; i < 4096; i += 512) Ps[(i >> 6) * 65 + (i & 63)] = p->pwq[(size_t)l * D * D + (size_t)(k0 + (i >> 6)) * D + h * 128 + j * 64 + (i & 63)];
            __syncthreads();
            const int kk = c.tid & 63, kg = c.tid >> 6;
            bf16_t* dst = (bf16_t*)(p->ws + WS_WPK) + (size_t)l * 2048 * D;
            for (int key = kg * 16; key < kg * 16 + 16; ++key) {
                float a = 0.f;
#pragma unroll 16
                for (int d = 0; d < 64; ++d) a += Ps[kk * 65 + d] * Ks[key * 65 + d];
                dst[(size_t)(h * 256 + j * 128 + key) * D + k0 + kk] = f2bf(a);
            }
            __syncthreads();
        }
    }
    const size_t gt = (size_t)bid * 512 + c.tid, gn = (size_t)G * 512;
    for (int task = c.gwave; task < 2 * DEPTH * NEXP; task += c.nwaves) {
        const int isv = task & 1, le = task >> 1, l = le >> 14, e = le & 16383; const int lane = c.lane;
        const float* src = (isv ? p->pv : p->pu) + (size_t)le * D + lane * 16; float f[16];
#pragma unroll
        for (int j = 0; j < 4; ++j) { const float4 q = *(const float4*)(src + 4 * j); f[4 * j] = q.x; f[4 * j + 1] = q.y; f[4 * j + 2] = q.z; f[4 * j + 3] = q.w; }
        float mx = 0.f;
#pragma unroll
        for (int j = 0; j < 16; ++j) mx = fmaxf(mx, fabsf(f[j]));
        mx = wmaxf(mx); const float sc = mx > 0.f ? 224.f / mx : 1.f;
        unsigned w[4];
#pragma unroll
        for (int j = 0; j < 4; ++j) { int pk = __builtin_amdgcn_cvt_pk_fp8_f32(f[4 * j] * sc, f[4 * j + 1] * sc, 0, false); pk = __builtin_amdgcn_cvt_pk_fp8_f32(f[4 * j + 2] * sc, f[4 * j + 3] * sc, pk, true); w[j] = (unsigned)pk; }
        if (!isv) *(uint4*)(p->ws + WS_U8 + (size_t)le * D + lane * 16) = make_uint4(w[0], w[1], w[2], w[3]);
        else *(uint4*)(p->ws + WS_V8 + (((size_t)l * 8 + (lane >> 3)) * NEXP + e) * 128 + (lane & 7) * 16) = make_uint4(w[0], w[1], w[2], w[3]);
        if (lane == 0) ((float*)(p->ws + (isv ? WS_SVI : WS_SUI)))[le] = 1.f / sc;
    }
    {   const size_t n4 = (size_t)DEPTH * NB * PAST * 128 / 4;
        const float4* sk = (const float4*)p->cache_a_k; const float4* sv = (const float4*)p->cache_a_v;
        for (size_t i = gt; i < n4; i += gn) { const size_t lb = i / (PAST * 32), rem = i % (PAST * 32); const size_t o = lb * (SKEYS * 32) + rem;
            const float4 a = sk[i]; u32x2v w; w.x = pk2bf(a.x, a.y); w.y = pk2bf(a.z, a.w); ((u32x2v*)(p->ws + WS_KAS))[o] = w;
            const float4 b = sv[i]; w.x = pk2bf(b.x, b.y); w.y = pk2bf(b.z, b.w); ((u32x2v*)(p->ws + WS_VAS))[o] = w; }
        const size_t m4 = (size_t)DEPTH * NB * PAST * 64 / 4; const float4* si = (const float4*)p->cache_idx_k;
        for (size_t i = gt; i < m4; i += gn) { const size_t lb = i / (PAST * 16), rem = i % (PAST * 16); const size_t o = lb * (SKEYS * 16) + rem;
            const float4 a = si[i]; u32x2v w; w.x = pk2bf(a.x, a.y); w.y = pk2bf(a.z, a.w); ((u32x2v*)(p->ws + WS_KIS))[o] = w; }
    }
    for (int task = c.gwave; task < DEPTH * NB * 128 * 2; task += c.nwaves) {
        const int kvh = task & 1, grp = (task >> 1) & 127, lb = task >> 8;
        const float* src = p->cache_a_v + ((size_t)lb * PAST + grp * 16) * 128 + kvh * 64 + c.lane;
        unsigned v[16];
#pragma unroll
        for (int i = 0; i < 16; ++i) v[i] = f2bf(src[(size_t)i * 128]);
        unsigned w[8];
#pragma unroll
        for (int i = 0; i < 8; ++i) { const int s0 = 2 * i, s1 = 2 * i + 1;
            const int o0 = 8 * ((s0 >> 2) & 1) + 4 * (s0 >> 3) + (s0 & 3), o1 = 8 * ((s1 >> 2) & 1) + 4 * (s1 >> 3) + (s1 & 3); w[i] = v[o0] | (v[o1] << 16); }
        bf16_t* dst = (bf16_t*)(p->ws + WS_VATS) + ((size_t)(lb * 2 + kvh) * 64 + c.lane) * SKP + grp * 16;
        *(uint4*)dst = make_uint4(w[0], w[1], w[2], w[3]); *(uint4*)(dst + 8) = make_uint4(w[4], w[5], w[6], w[7]);
    }
    for (size_t i = gt; i < (size_t)DEPTH * NB * SBT * 128; i += gn) { const size_t lb = i / (SBT * 128), rem = i % (SBT * 128);
        const float4 a = ((const float4*)p->cache_b_k)[(lb * PAST + (PAST - SBT)) * 128 + rem]; u32x2v w; w.x = pk2bf(a.x, a.y); w.y = pk2bf(a.z, a.w); ((u32x2v*)(p->ws + WS_KBS))[lb * (SBL * 128) + rem] = w; }
    for (int task = c.gwave; task < DEPTH * NB * 8 * (SBT / 16); task += c.nwaves) {
        const int grp = task % (SBT / 16), h = (task / (SBT / 16)) & 7, lb = task / ((SBT / 16) * 8);
        const float* src = p->cache_b_v + ((size_t)lb * PAST + (PAST - SBT) + grp * 16) * 512 + h * 64 + c.lane;
        unsigned v[16];
#pragma unroll
        for (int i = 0; i < 16; ++i) v[i] = f2bf(src[(size_t)i * 512]);
        unsigned w[8];
#pragma unroll
        for (int i = 0; i < 8; ++i) { const int s0 = 2 * i, s1 = 2 * i + 1;
            const int o0 = 8 * ((s0 >> 2) & 1) + 4 * (s0 >> 3) + (s0 & 3), o1 = 8 * ((s1 >> 2) & 1) + 4 * (s1 >> 3) + (s1 & 3); w[i] = v[o0] | (v[o1] << 16); }
        bf16_t* dst = (bf16_t*)(p->ws + WS_VBTS) + ((size_t)(lb * 8 + h) * 64 + c.lane) * SBL + grp * 16;
        *(uint4*)dst = make_uint4(w[0], w[1], w[2], w[3]); *(uint4*)(dst + 8) = make_uint4(w[4], w[5], w[6], w[7]);
    }
    {   float2* rt = (float2*)(p->ws + WS_ROPE);
        for (size_t i = gt; i < (size_t)SKEYS * 32; i += gn) { const int pos = (int)(i >> 5), d = (int)(i & 31);
            const float inv = exp2f(-(float)d * (13.287712379549449f / 32.f)); const float ang = (float)pos * inv; float s, co; sincosf(ang, &s, &co); rt[i] = make_float2(co, s); }
    }
}

__device__ __forceinline__ void phase_rms(PP p, const Ctx& c, const float* gain, bool from_input) {
    bf16_t* h = (bf16_t*)(p->ws + WS_H); float* xb = p->out;
    float4 g[4];
#pragma unroll
    for (int j = 0; j < 4; ++j) g[j] = *(const float4*)(gain + j * 256 + c.lane * 4);
#define RMS_SRC(r_) (from_input ? ((r_) < MP ? p->x_prompt + (size_t)(r_) * D : p->x_sample + (size_t)((r_) - MP) * D) : xb + (size_t)(r_) * D)
    float4 vn[4];
    { const int r0 = c.gwave < MT ? c.gwave : MT - 1; const float* xr = RMS_SRC(r0);
#pragma unroll
      for (int j = 0; j < 4; ++j) vn[j] = *(const float4*)(xr + j * 256 + c.lane * 4); }
    for (int r = c.gwave; r < MT; r += c.nwaves) {
        float4 v[4];
#pragma unroll
        for (int j = 0; j < 4; ++j) v[j] = vn[j];
        { const int rn = r + c.nwaves < MT ? r + c.nwaves : MT - 1; const float* xr = RMS_SRC(rn);
#pragma unroll
          for (int j = 0; j < 4; ++j) vn[j] = *(const float4*)(xr + j * 256 + c.lane * 4); }
        float ss = 0.f;
#pragma unroll
        for (int j = 0; j < 4; ++j) ss += v[j].x * v[j].x + v[j].y * v[j].y + v[j].z * v[j].z + v[j].w * v[j].w;
        ss = wsum(ss); const float sc = rsqrtf(ss * (1.f / D) + EPS);
#pragma unroll
        for (int j = 0; j < 4; ++j) { u32x2v w; w.x = pk2bf(v[j].x * sc * g[j].x, v[j].y * sc * g[j].y); w.y = pk2bf(v[j].z * sc * g[j].z, v[j].w * sc * g[j].w);
            *(u32x2v*)(h + (size_t)r * D + j * 256 + c.lane * 4) = w;
            { int pk = __builtin_amdgcn_cvt_pk_fp8_f32(v[j].x * sc * g[j].x, v[j].y * sc * g[j].y, 0, false); pk = __builtin_amdgcn_cvt_pk_fp8_f32(v[j].z * sc * g[j].z, v[j].w * sc * g[j].w, pk, true); *(int*)(p->ws + WS_X8 + (size_t)r * D + j * 256 + c.lane * 4) = pk; }
            if (from_input) *(float4*)(xb + (size_t)r * D + j * 256 + c.lane * 4) = v[j]; }
    }
#undef RMS_SRC
}

__device__ __forceinline__ float rope1(float y, int lane, float2 cs) { const float o = __shfl_xor(y, 32); return lane < 32 ? y * cs.x - o * cs.y : y * cs.x + o * cs.y; }
__device__ __forceinline__ void phase_post(PP p, const Ctx& c, int layer) {
    const bf16_t* praw = (const bf16_t*)(p->ws + WS_PRAW); const float2* rt = (const float2*)(p->ws + WS_ROPE);
    const int lane = c.lane, j8 = (lane & 7) * 8; const bool lowhalf = (lane & 4) == 0;
    float qg[8], kg[8], ig[8];
#pragma unroll
    for (int e = 0; e < 8; ++e) { qg[e] = p->qn[layer * 64 + j8 + e]; kg[e] = p->kn[layer * 64 + j8 + e]; ig[e] = p->ikn[layer * 64 + j8 + e]; }
#define LD8(ptr, f) do { const uint4 q_ = *(const uint4*)(ptr); UNPK8(q_, f); } while (0)
#define ST8(ptr, f) do { uint4 q_; q_.x = pk2bf((f)[0], (f)[1]); q_.y = pk2bf((f)[2], (f)[3]); q_.z = pk2bf((f)[4], (f)[5]); q_.w = pk2bf((f)[6], (f)[7]); *(uint4*)(ptr) = q_; } while (0)
#define ST8F(ptr, f) do { *(float4*)(ptr) = make_float4((f)[0], (f)[1], (f)[2], (f)[3]); *(float4*)((ptr) + 4) = make_float4((f)[4], (f)[5], (f)[6], (f)[7]); } while (0)
#define HEADNORM(f, g) do { float ss_ = 0.f; _Pragma("unroll") for (int e = 0; e < 8; ++e) ss_ += (f)[e] * (f)[e]; ss_ += __shfl_xor(ss_, 1); ss_ += __shfl_xor(ss_, 2); ss_ += __shfl_xor(ss_, 4); \
        const float sc_ = rsqrtf(ss_ * (1.f / 64) + EPS); _Pragma("unroll") for (int e = 0; e < 8; ++e) (f)[e] = (f)[e] * sc_ * (g)[e]; } while (0)
#define ROPE8(f) do { _Pragma("unroll") for (int e = 0; e < 8; ++e) { const float o_ = __shfl_xor((f)[e], 4); (f)[e] = lowhalf ? (f)[e] * cs[e].x - o_ * cs[e].y : (f)[e] * cs[e].x + o_ * cs[e].y; } } while (0)
    for (int r = c.gwave; r < MT; r += c.nwaves) {
        const bool samp = r >= MP; int b, t, pos;
        if (!samp) { b = r >> 11; t = r & 2047; pos = t; } else { const int rr = r - MP; b = rr >> 4; t = rr & 15; pos = PAST + t; }
        const bf16_t* pr = praw + (size_t)r * NINP;
        float2 cs[8];
#pragma unroll
        for (int e = 0; e < 4; ++e) { const float4 q = *(const float4*)(rt + pos * 32 + (j8 & 31) + 2 * e); cs[2 * e] = make_float2(q.x, q.y); cs[2 * e + 1] = make_float2(q.z, q.w); }
        const size_t tok = samp ? (size_t)(layer * NB + b) * DSEQ + t : (size_t)(layer * NB + b) * SEQ + t;
        const size_t kpos = samp ? ((size_t)(layer * NB + b) * SKEYS + pos) : ((size_t)b * SEQ + pos);
        float f[8];
        LD8(pr + C_QA + lane * 8, f); HEADNORM(f, qg); ROPE8(f); ST8((bf16_t*)(p->ws + WS_QA) + (size_t)r * 512 + lane * 8, f);
        LD8(pr + C_QI + lane * 8, f); ROPE8(f); ST8((bf16_t*)(p->ws + WS_QI) + (size_t)r * 512 + lane * 8, f);
        {   const int col = lane < 32 ? C_KA + lane * 8 : (lane < 40 ? C_KI + (lane - 32) * 8 : C_WI);
            LD8(pr + col, f);
            float g[8];
#pragma unroll
            for (int e = 0; e < 8; ++e) g[e] = lane < 32 ? kg[e] : ig[e];
            float fn[8];
#pragma unroll
            for (int e = 0; e < 8; ++e) fn[e] = f[e];
            HEADNORM(fn, g); ROPE8(fn);
            if (lane < 16) { ST8F(p->out + (samp ? O_AKS : O_AKP) + tok * 128 + lane * 8, fn); ST8((bf16_t*)(p->ws + (samp ? WS_KAS : WS_KAP)) + kpos * 128 + lane * 8, fn); }

            else if (lane >= 32 && lane < 40) { ST8F(p->out + (samp ? O_IKS : O_IKP) + tok * 64 + (lane - 32) * 8, fn); ST8((bf16_t*)(p->ws + (samp ? WS_KIS : WS_KIP)) + kpos * 64 + (lane - 32) * 8, fn); }
            else if (lane == 40) { float* wo = (float*)(p->ws + WS_WI) + (size_t)r * 8;
#pragma unroll
                for (int e = 0; e < 8; ++e) f[e] *= (0.125f * 0.35355339059327373f);
                ST8F(wo, f); }
        }
    }
#undef LD8
#undef ST8
#undef ST8F
#undef HEADNORM
#undef ROPE8
}

__device__ __forceinline__ float ukey2f(unsigned k) { return (k & 0x80000000u) ? __uint_as_float(k ^ 0x80000000u) : __uint_as_float(~k); }
constexpr int DS_NSLOT = 17;
__device__ __forceinline__ void phase_dsa_select(PP p, const Ctx& c, int layer, int rep) {
    const int lane = c.lane, q = lane & 15, g = lane >> 4, wave = c.wave, tid = c.tid;
    int* cnt = (int*)c.lds;
    float* mmn = (float*)(c.lds + 3072); float* mmx = mmn + 128;
    unsigned* lmask = (unsigned*)(c.lds + 4096);
    unsigned* leq = (unsigned*)(c.lds + 8448);
    unsigned* M = (unsigned*)(p->ws + WS_MASK);
    const bf16_t* qiw = (const bf16_t*)(p->ws + WS_QI); const float* wiw = (const float*)(p->ws + WS_WI);
    unsigned* ctr = (unsigned*)(p->ws + WS_CTR) + (size_t)(layer * CTR_PER_LAYER + 120 + rep) * 64;
    int* tsel = (int*)(c.lds + 12800);
    for (;;) {
        if (tid == 0) *tsel = (int)__hip_atomic_fetch_add(ctr, 1u, __ATOMIC_RELAXED, __HIP_MEMORY_SCOPE_AGENT);
        __syncthreads();
        const int ord = *tsel;
        if (ord >= 1032) break;
        int tile;
        if (ord < 8) tile = 1024 + ord; else { const int i = ord - 8, cch = 31 - (i >> 5), j = i & 31; tile = (j >> 2) * 128 + cch * 4 + (j & 3); }
        int r0, n; const bf16_t* kI;
        if (tile < 1024) { const int b = tile >> 7, t0 = (tile & 127) * 16; r0 = tile * 16; n = ((t0 >> 6) + 1) * 64; kI = (const bf16_t*)(p->ws + WS_KIP) + (size_t)b * SEQ * 64; }
        else { const int b = tile - 1024; r0 = MP + b * 16; n = SKEYS; kI = (const bf16_t*)(p->ws + WS_KIS) + (size_t)(layer * NB + b) * SKEYS * 64; }
        const int ntiles = n >> 4;
        for (int i = tid; i < 768; i += 512) cnt[i] = 0;
        for (int i = tid; i < 65 * 16; i += 512) { lmask[i] = 0u; leq[i] = 0u; }
        __syncthreads();
        bf16x8 bq[8][2]; float w[8];
#pragma unroll
        for (int h = 0; h < 8; ++h) { w[h] = wiw[(size_t)(r0 + q) * 8 + h];
#pragma unroll
            for (int s = 0; s < 2; ++s) bq[h][s] = *(const bf16x8*)(qiw + (size_t)(r0 + q) * 512 + h * 64 + 32 * s + 8 * g); }
        float sc[DS_NSLOT][4];
#pragma unroll
        for (int i0 = 0; i0 < DS_NSLOT; i0 += 6) {
            bf16x8 ka[6][2];
#pragma unroll
            for (int ii = 0; ii < 6; ++ii) if (i0 + ii < DS_NSLOT) { const int kt = wave + 8 * (i0 + ii), ktc = kt < ntiles ? kt : ntiles - 1;
                ka[ii][0] = *(const bf16x8*)(kI + (size_t)(16 * ktc + q) * 64 + 8 * g); ka[ii][1] = *(const bf16x8*)(kI + (size_t)(16 * ktc + q) * 64 + 32 + 8 * g); }
            asm volatile("" ::: "memory");
#pragma unroll
            for (int ii = 0; ii < 6; ++ii) if (i0 + ii < DS_NSLOT) { const int i = i0 + ii, kt = wave + 8 * i;
                if (kt < ntiles) {
                    f32x4 s4 = {0.f, 0.f, 0.f, 0.f};
#pragma unroll
                    for (int h = 0; h < 8; ++h) { f32x4 a = {0.f, 0.f, 0.f, 0.f}; a = __builtin_amdgcn_mfma_f32_16x16x32_bf16(ka[ii][0], bq[h][0], a, 0, 0, 0); a = __builtin_amdgcn_mfma_f32_16x16x32_bf16(ka[ii][1], bq[h][1], a, 0, 0, 0);
#pragma unroll
                        for (int r = 0; r < 4; ++r) s4[r] += fmaxf(a[r], 0.f) * w[h]; }
#pragma unroll
                    for (int r = 0; r < 4; ++r) sc[i][r] = s4[r] + 0.f;
                } else {
#pragma unroll
                    for (int r = 0; r < 4; ++r) sc[i][r] = -__builtin_inff();
                } }
        }
        bool tie = false; float T = -__builtin_inff(), lo = 0.f; int chi = 0;
        if (n > TOPK) {
            float mn = __builtin_inff(), mx = -__builtin_inff();
#pragma unroll
            for (int i = 0; i < DS_NSLOT; ++i) if (wave + 8 * i < ntiles) {
#pragma unroll
                for (int r = 0; r < 4; ++r) { mn = fminf(mn, sc[i][r]); mx = fmaxf(mx, sc[i][r]); } }
            mn = fminf(mn, __shfl_xor(mn, 16)); mn = fminf(mn, __shfl_xor(mn, 32)); mx = fmaxf(mx, __shfl_xor(mx, 16)); mx = fmaxf(mx, __shfl_xor(mx, 32));
            if (g == 0) { mmn[wave * 16 + q] = mn; mmx[wave * 16 + q] = mx; }
            __syncthreads();
#pragma unroll
            for (int w8 = 0; w8 < 8; ++w8) { mn = fminf(mn, mmn[w8 * 16 + q]); mx = fmaxf(mx, mmx[w8 * 16 + q]); }
            lo = mn; float hi = ukey2f(fkey(mx) + 1u); bool done = false;
            for (int it = 0; it < 48; ++it) {
                const float mid = lo + 0.5f * (hi - lo);
                if (!done && !(mid > lo && mid < hi)) { done = true; tie = true; }
                if (__all(done)) break;
                int cl = 0;
#pragma unroll
                for (int i = 0; i < DS_NSLOT; ++i) if (wave + 8 * i < ntiles) {
#pragma unroll
                    for (int r = 0; r < 4; ++r) cl += (sc[i][r] >= mid) ? 1 : 0; }
                cl += __shfl_xor(cl, 16); cl += __shfl_xor(cl, 32);
                if (g == 0) atomicAdd(&cnt[it * 16 + q], cl);
                __syncthreads();
                const int ct = cnt[it * 16 + q];
                if (!done) { if (ct == TOPK) { done = true; T = mid; } else if (ct > TOPK) lo = mid; else { hi = mid; chi = ct; } }
            }
            if (tie) T = hi;
        }
#pragma unroll
        for (int i = 0; i < DS_NSLOT; ++i) {
            const int kt = wave + 8 * i;
            if (kt < ntiles) {
                unsigned nb = 0u, ne = 0u;
#pragma unroll
                for (int r = 0; r < 4; ++r) { nb |= (sc[i][r] >= T) ? (1u << r) : 0u; ne |= (tie && sc[i][r] == lo) ? (1u << r) : 0u; }
                nb <<= 4 * g; ne <<= 4 * g;
                nb |= __shfl_xor(nb, 16); nb |= __shfl_xor(nb, 32); ne |= __shfl_xor(ne, 16); ne |= __shfl_xor(ne, 32);
                if (g == 0) { atomicOr(&lmask[(kt >> 1) * 16 + q], nb << (16 * (kt & 1))); if (ne) atomicOr(&leq[(kt >> 1) * 16 + q], ne << (16 * (kt & 1))); }
            }
        }
        __syncthreads();
        if (wave == 0 && g == 0 && tie) { int need = TOPK - chi;
            for (int kg = 0; kg < 65 && need > 0; ++kg) { unsigned e = leq[kg * 16 + q]; unsigned add = 0u;
                while (e && need > 0) { const unsigned bit = e & (0u - e); add |= bit; e ^= bit; --need; }
                if (add) lmask[kg * 16 + q] |= add; } }
        __syncthreads();
        for (int i = tid; i < 65 * 16; i += 512) M[(size_t)(i >> 4) * MT + r0 + (i & 15)] = lmask[i];
        __syncthreads();
    }
}

constexpr int DA_ST = 8448, DA_NST = 4, DA_PD = 3;
__device__ __forceinline__ void phase_dsa_attn(PP p, const Ctx& c, int layer, int ctr_off) {
    const int lane = c.lane, ql = lane & 31, half = lane >> 5, wave = c.wave, tid = c.tid;
    unsigned* ctr = (unsigned*)(p->ws + WS_CTR) + (size_t)(layer * CTR_PER_LAYER + 32 + ctr_off * 40) * 64;
    const unsigned* M = (const unsigned*)(p->ws + WS_MASK); const bf16_t* qa = (const bf16_t*)(p->ws + WS_QA); bf16_t* oa = (bf16_t*)(p->ws + WS_OA);
    unsigned char* ring = c.lds; int* isel = (int*)(c.lds + DA_NST * DA_ST);
    const int hh = wave & 3, qq = wave >> 2;
    for (;;) {
        if (tid == 0) *isel = (int)__hip_atomic_fetch_add(ctr, 1u, __ATOMIC_RELAXED, __HIP_MEMORY_SCOPE_AGENT);
        __syncthreads();
        const int it = *isel;
        __syncthreads();
        if (it >= 16 + 512) break;
        int kvh, r0, ngrp, pitch, nq; const bf16_t *kA, *vT;
        if (it < 16) { const int b = it >> 1; kvh = it & 1; r0 = MP + b * 16; ngrp = 65; pitch = SKP; nq = 16;
            kA = (const bf16_t*)(p->ws + WS_KAS) + (size_t)(layer * NB + b) * SKEYS * 128; vT = (const bf16_t*)(p->ws + WS_VATS) + (size_t)((layer * NB + b) * 2 + kvh) * 64 * SKP; }
        else { const int j = it - 16, cch = 31 - (j >> 4), b = (j >> 1) & 7; kvh = j & 1; r0 = b * SEQ + cch * 64; ngrp = 2 * (cch + 1); pitch = SEQ; nq = 64;
            kA = (const bf16_t*)(p->ws + WS_KAP) + (size_t)b * SEQ * 128; vT = (const bf16_t*)(p->ws + WS_VAT) + (size_t)(b * 2 + kvh) * 64 * SEQ; }
        const int h = 4 * kvh + hh; const int qrow = nq == 64 ? r0 + 32 * qq + ql : r0 + (ql & 15); const bool active = nq == 64 || qq == 0; const bool store = nq == 64 || (qq == 0 && ql < 16);
        bf16x8 qf[4];
#pragma unroll
        for (int s = 0; s < 4; ++s) qf[s] = *(const bf16x8*)(qa + (size_t)qrow * 512 + h * 64 + 16 * s + 8 * half);
        asm volatile("s_waitcnt vmcnt(0)" ::: "memory");
        const int pk = (wave & 3) * 64 + lane;
        const bf16_t* gsrc; size_t gstep;
        if (wave < 4) { const int key = pk >> 3, pc = (pk & 7) ^ (key & 7); gsrc = kA + (size_t)key * 128 + kvh * 64 + pc * 8; gstep = (size_t)32 * 128; }
        else { const int d = pk >> 2, pc = (pk & 3) ^ ((d >> 2) & 3); gsrc = vT + (size_t)d * pitch + pc * 8; gstep = 32; }
        const unsigned* msrc = M + (nq == 64 ? r0 + lane : r0 + (lane & 15));
#define DA_ISSUE(g_) do { unsigned char* st_ = ring + ((g_) % DA_NST) * DA_ST; \
            __builtin_amdgcn_global_load_lds((const unsigned*)(gsrc + (size_t)(g_) * gstep), (LAS unsigned*)(st_ + wave * 1024), 16, 0, 0); \
            if (wave == 0) __builtin_amdgcn_global_load_lds(msrc + (size_t)(g_) * MT, (LAS unsigned*)(st_ + 8192), 4, 0, 0); } while (0)
#pragma unroll
        for (int g = 0; g < DA_PD; ++g) if (g < ngrp) DA_ISSUE(g);
        f32x16 o0, o1;
#pragma unroll
        for (int r = 0; r < 16; ++r) { o0[r] = 0.f; o1[r] = 0.f; }
        float mrun = -1.0e30f, l = 0.f;
        for (int kg = 0; kg < ngrp; ++kg) {
            if (kg + DA_PD - 1 < ngrp) { if (wave == 0) asm volatile("s_waitcnt vmcnt(4)" ::: "memory"); else asm volatile("s_waitcnt vmcnt(2)" ::: "memory"); }
            else asm volatile("s_waitcnt vmcnt(0)" ::: "memory");
            __builtin_amdgcn_s_barrier();
            if (kg + DA_PD < ngrp) DA_ISSUE(kg + DA_PD);
            if (active) {
                const unsigned char* st = ring + (kg % DA_NST) * DA_ST;
                const unsigned mw = *(const unsigned*)(st + 8192 + (nq == 64 ? 32 * qq + ql : (ql & 15)) * 4) >> (4 * half);
                f32x16 sacc;
#pragma unroll
                for (int r = 0; r < 16; ++r) sacc[r] = 0.f;
#pragma unroll
                for (int s = 0; s < 4; ++s) { const bf16x8 ka = *(const bf16x8*)(st + ql * 128 + (((2 * s + half) ^ (ql & 7)) * 16)); sacc = __builtin_amdgcn_mfma_f32_32x32x16_bf16(ka, qf[s], sacc, 0, 0, 0); }
                float sv[16]; float mt = -1.0e30f;
#pragma unroll
                for (int r = 0; r < 16; ++r) { const bool on = (mw >> (8 * (r >> 2) + (r & 3))) & 1u; sv[r] = on ? sacc[r] * 0.125f : -1.0e30f; mt = fmaxf(mt, sv[r]); }
                mt = fmaxf(mt, __shfl_xor(mt, 32));
                const float mnew = fmaxf(mrun, mt), alpha = __expf(mrun - mnew); mrun = mnew;
                float pr[16], ls = 0.f;
#pragma unroll
                for (int r = 0; r < 16; ++r) { const bool on = (mw >> (8 * (r >> 2) + (r & 3))) & 1u; pr[r] = on ? __expf(sv[r] - mnew) : 0.f; ls += pr[r]; }
                l = l * alpha + ls;
                if (!__all(alpha == 1.f)) {
#pragma unroll
                    for (int r = 0; r < 16; ++r) { o0[r] *= alpha; o1[r] *= alpha; } }
#pragma unroll
                for (int s2 = 0; s2 < 2; ++s2) {
                    u32x4v pw; pw.x = pg8::cvt_pk_bf16(pr[8 * s2], pr[8 * s2 + 1]); pw.y = pg8::cvt_pk_bf16(pr[8 * s2 + 2], pr[8 * s2 + 3]); pw.z = pg8::cvt_pk_bf16(pr[8 * s2 + 4], pr[8 * s2 + 5]); pw.w = pg8::cvt_pk_bf16(pr[8 * s2 + 6], pr[8 * s2 + 7]);
                    const bf16x8 pb = __builtin_bit_cast(bf16x8, pw);
                    const int d0 = ql, d1 = 32 + ql;
                    const bf16x8 va0 = *(const bf16x8*)(st + 4096 + d0 * 64 + (((2 * s2 + half) ^ ((d0 >> 2) & 3)) * 16));
                    const bf16x8 va1 = *(const bf16x8*)(st + 4096 + d1 * 64 + (((2 * s2 + half) ^ ((d1 >> 2) & 3)) * 16));
                    o0 = __builtin_amdgcn_mfma_f32_32x32x16_bf16(va0, pb, o0, 0, 0, 0); o1 = __builtin_amdgcn_mfma_f32_32x32x16_bf16(va1, pb, o1, 0, 0, 0); }
            }
        }
#undef DA_ISSUE
        l += __shfl_xor(l, 32); const float inv = 1.f / l;
        if (store) { bf16_t* orow = oa + (size_t)qrow * 512 + h * 64;
#pragma unroll
            for (int a = 0; a < 4; ++a) { u32x2v w0, w1; const int d = 8 * a + 4 * half;
                w0.x = pk2bf(o0[4 * a] * inv, o0[4 * a + 1] * inv); w0.y = pk2bf(o0[4 * a + 2] * inv, o0[4 * a + 3] * inv); w1.x = pk2bf(o1[4 * a] * inv, o1[4 * a + 1] * inv); w1.y = pk2bf(o1[4 * a + 2] * inv, o1[4 * a + 3] * inv);
                *(u32x2v*)(orow + d) = w0; *(u32x2v*)(orow + 32 + d) = w1; } }
        asm volatile("s_waitcnt vmcnt(0)" ::: "memory");
        __syncthreads();
    }
}

__device__ __forceinline__ float sb_tail_row(PP p, int layer, int b, int h, int r, int nk, float* qf, int lane) {
    WSYNC(); qf[lane] = bf2f(((const bf16_t*)(p->ws + WS_QB))[(size_t)r * 512 + h * 64 + lane]); WSYNC();
    const float* kBc = p->cache_b_k + ((size_t)(layer * NB + b) * PAST) * 512 + h * 64; const float* vBc = p->cache_b_v + ((size_t)(layer * NB + b) * PAST) * 512 + h * 64;
    float carry = 0.f, o = 0.f;
    for (int top = nk - 1; top >= 0; top -= 64) {
        const int s = top - lane; const bool valid = s >= 0; float z = 0.f;
        if (valid) { const float4* kr = (const float4*)(kBc + (size_t)s * 512);
#pragma unroll
            for (int c4 = 0; c4 < 16; ++c4) { const float4 kv = kr[c4]; z += qf[c4 * 4] * kv.x + qf[c4 * 4 + 1] * kv.y + qf[c4 * 4 + 2] * kv.z + qf[c4 * 4 + 3] * kv.w; }
            z *= 0.125f; }
        const float lr = valid ? -softplusf(z) : 0.f;
        float inc = lr;
#pragma unroll
        for (int off = 1; off < 64; off <<= 1) { const float t = __shfl_up(inc, off); if (lane >= off) inc += t; }
        const float after = carry + inc - lr;
        const float att = valid ? __expf(-softplusf(-z) + after) : 0.f;
        const int cnt = top + 1 < 64 ? top + 1 : 64;
        for (int j = 0; j < cnt; ++j) { const float a = rdlane(att, j); o += a * vBc[(size_t)(top - j) * 512 + lane]; }
        carry += rdlane(inc, 63);
        if (carry < -104.f) break;
    }
    return o;
}

__device__ __forceinline__ void phase_sb_mfma(PP p, const Ctx& c, int layer) {
    const int lane = c.lane, ql = lane & 31, half = lane >> 5;
    const bf16_t* qb = (const bf16_t*)(p->ws + WS_QB); const bf16_t* kB = (const bf16_t*)(p->ws + WS_KBP); const bf16_t* vT = (const bf16_t*)(p->ws + WS_VBT); bf16_t* ob = (bf16_t*)(p->ws + WS_OB);
    for (int item = c.gwave; item < NB * 8 * 64 + 64; item += c.nwaves) {
        const bool samp = item >= NB * 8 * 64;
        const int h = item & 7, b = (item >> 3) & 7; const int qt = samp ? 7 : 63 - (item >> 6), q0 = qt * 32;
        const int qpos = samp ? SBT + (ql & 15) : q0 + ql; const size_t qrow = samp ? (size_t)MP + b * DSEQ + (ql & 15) : (size_t)b * SEQ + q0 + ql;
        const bf16_t* kBi = samp ? (const bf16_t*)(p->ws + WS_KBS) + (size_t)(layer * NB + b) * SBL * 512 : kB + (size_t)b * SEQ * 512;
        const bf16_t* vTi = samp ? (const bf16_t*)(p->ws + WS_VBTS) + (size_t)((layer * NB + b) * 8 + h) * 64 * SBL : vT + (size_t)(b * 8 + h) * 64 * SEQ;
        const int vpitch = samp ? SBL : SEQ;
        bf16x8 qf[4];
#pragma unroll
        for (int s = 0; s < 4; ++s) qf[s] = *(const bf16x8*)(qb + qrow * 512 + h * 64 + 16 * s + 8 * half);
        f32x16 o0, o1;
#pragma unroll
        for (int r = 0; r < 16; ++r) { o0[r] = 0.f; o1[r] = 0.f; }
        float carry = 1.f;
        for (int kt = qt; kt >= 0; --kt) {
            const int k0 = kt * 32;
            f32x16 st;
#pragma unroll
            for (int r = 0; r < 16; ++r) st[r] = 0.f;
#pragma unroll
            for (int s = 0; s < 4; ++s) { const bf16x8 ka = *(const bf16x8*)(kBi + (size_t)(k0 + ql) * 512 + h * 64 + 16 * s + 8 * half); st = __builtin_amdgcn_mfma_f32_32x32x16_bf16(ka, qf[s], st, 0, 0, 0); }
            float om[16], sg[16];
#pragma unroll
            for (int r = 0; r < 16; ++r) { const int key = k0 + 8 * (r >> 2) + 4 * half + (r & 3); const bool valid = key < qpos;
                float z = st[r] * 0.125f; z = fminf(fmaxf(z, -80.f), 80.f); const float e = __expf(z); const float rr = __builtin_amdgcn_rcpf(1.f + e);
                om[r] = valid ? rr : 1.f; sg[r] = valid ? e * rr : 0.f; }
            float G[4], Go[4];
#pragma unroll
            for (int a = 0; a < 4; ++a) { G[a] = (om[4 * a] * om[4 * a + 1]) * (om[4 * a + 2] * om[4 * a + 3]); Go[a] = __shfl_xor(G[a], 32); }
            float suf = 1.f; float att[16];
#pragma unroll
            for (int a = 3; a >= 0; --a) { const float Sa = (half == 0 ? suf * Go[a] : suf) * carry;
                const float R3 = Sa, R2 = R3 * om[4 * a + 3], R1 = R2 * om[4 * a + 2], R0 = R1 * om[4 * a + 1];
                att[4 * a + 3] = sg[4 * a + 3] * R3; att[4 * a + 2] = sg[4 * a + 2] * R2; att[4 * a + 1] = sg[4 * a + 1] * R1; att[4 * a] = sg[4 * a] * R0;
                suf = suf * (G[a] * Go[a]); }
            carry *= suf;
#pragma unroll
            for (int s2 = 0; s2 < 2; ++s2) {
                u32x4v pw; pw.x = pg8::cvt_pk_bf16(att[8 * s2], att[8 * s2 + 1]); pw.y = pg8::cvt_pk_bf16(att[8 * s2 + 2], att[8 * s2 + 3]); pw.z = pg8::cvt_pk_bf16(att[8 * s2 + 4], att[8 * s2 + 5]); pw.w = pg8::cvt_pk_bf16(att[8 * s2 + 6], att[8 * s2 + 7]);
                const bf16x8 pb = __builtin_bit_cast(bf16x8, pw);
                const bf16x8 va0 = *(const bf16x8*)(vTi + (size_t)ql * vpitch + k0 + 16 * s2 + 8 * half);
                const bf16x8 va1 = *(const bf16x8*)(vTi + (size_t)(32 + ql) * vpitch + k0 + 16 * s2 + 8 * half);
                o0 = __builtin_amdgcn_mfma_f32_32x32x16_bf16(va0, pb, o0, 0, 0, 0); o1 = __builtin_amdgcn_mfma_f32_32x32x16_bf16(va1, pb, o1, 0, 0, 0); }
            if (__all(carry == 0.f)) break;
        }
        if (!samp || ql < 16) { bf16_t* orow = ob + qrow * 512 + h * 64;
#pragma unroll
            for (int a = 0; a < 4; ++a) { u32x2v w0, w1; const int d = 8 * a + 4 * half;
                w0.x = pk2bf(o0[4 * a], o0[4 * a + 1]); w0.y = pk2bf(o0[4 * a + 2], o0[4 * a + 3]); w1.x = pk2bf(o1[4 * a], o1[4 * a + 1]); w1.y = pk2bf(o1[4 * a + 2], o1[4 * a + 3]);
                *(u32x2v*)(orow + d) = w0; *(u32x2v*)(orow + 32 + d) = w1; } }
        if (samp && !__all(carry == 0.f)) {
            asm volatile("s_waitcnt vmcnt(0)" ::: "memory");
            for (int qi = 0; qi < 16; ++qi) { const float cq = rdlane(carry, qi); if (cq == 0.f) continue;
                const int r = MP + b * DSEQ + qi; const float orest = sb_tail_row(p, layer, b, h, r, PAST - SBT, (float*)c.lds + c.wave * 64, lane);
                bf16_t* o1p = ob + (size_t)r * 512 + h * 64 + lane; *o1p = f2bf(bf2f(*o1p) + cq * orest); }
        }
    }
}

#define CEX(x, y) do { const unsigned lo_ = __builtin_elementwise_min(x, y), hi_ = __builtin_elementwise_max(x, y); x = lo_; y = hi_; } while (0)
template <bool DESC> __device__ __forceinline__ void bitonic_sort16(unsigned (&a)[16]) {
#pragma unroll
    for (int k = 2; k <= 16; k <<= 1)
#pragma unroll
        for (int j = k >> 1; j > 0; j >>= 1)
#pragma unroll
            for (int i = 0; i < 16; ++i) { const int l = i ^ j; if (l > i) { const bool up = (((i & k) == 0) != DESC); if (up) CEX(a[i], a[l]); else CEX(a[l], a[i]); } }
}
__device__ __forceinline__ void bitonic_merge16_desc(unsigned (&a)[16]) {
#pragma unroll
    for (int j = 8; j > 0; j >>= 1)
#pragma unroll
        for (int i = 0; i < 16; ++i) { const int l = i ^ j; if (l > i) CEX(a[l], a[i]); }
}
__device__ __forceinline__ void phase_peer_select(PP p, const Ctx& c) {
    const int lane = c.lane, sub = lane & 7; const float* sT = (const float*)(p->ws + WS_PRAW);
    float* tvl = (float*)c.lds + (size_t)c.wave * 4096 + lane; int* til = (int*)c.lds + (size_t)c.wave * 4096 + 2048 + lane;
    for (int task = c.gwave; task < MS; task += c.nwaves) {
        const int pr = task * 8 + (lane >> 3), h = pr & 7, tok = MP + (pr >> 3);
        float tv[2][16];
#pragma unroll
        for (int side = 0; side < 2; ++side) {
            const float* base = sT + (size_t)(h * 256 + side * 128) * MT + tok;
            unsigned top[16];
#pragma unroll
            for (int i = 0; i < 16; ++i) top[i] = (fkey(base[(size_t)(sub * 16 + i) * MT]) & ~127u) | (unsigned)(127 - sub * 16 - i);
            bitonic_sort16<true>(top);
#pragma unroll
            for (int mk = 1; mk < 8; mk <<= 1) {
                unsigned o[16];
#pragma unroll
                for (int i = 0; i < 16; ++i) o[i] = (unsigned)__shfl_xor((int)top[15 - i], mk);
#pragma unroll
                for (int i = 0; i < 16; ++i) top[i] = __builtin_elementwise_max(top[i], o[i]);
                bitonic_merge16_desc(top); }
#pragma unroll
            for (int i = 0; i < 16; ++i) { const int k = 127 - (int)(top[i] & 127u); const float ex = base[(size_t)k * MT]; til[(side * 16 + i) * 64] = k; tvl[(side * 16 + i) * 64] = ex; tv[side][i] = ex; }
        }
        unsigned top[16];
#pragma unroll
        for (int g = 0; g < 4; ++g) {
            unsigned s[16];
#pragma unroll
            for (int i = 0; i < 16; ++i) s[i] = 0u;
            { int cnt = 0;
#pragma unroll
              for (int a = 0; a < 16; ++a)
#pragma unroll
                for (int b = 0; b < 16; ++b) if ((a + 1) * (b + 1) <= 16) { if (cnt / 16 == g) s[cnt % 16] = (fkey(tv[0][a] + tv[1][b]) & ~255u) | (unsigned)(255 - (a * 16 + b)); ++cnt; } }
            if (g == 0) { bitonic_sort16<true>(s);
#pragma unroll
                for (int i = 0; i < 16; ++i) top[i] = s[i]; }
            else { bitonic_sort16<false>(s);
#pragma unroll
                for (int i = 0; i < 16; ++i) top[i] = __builtin_elementwise_max(top[i], s[i]);
                bitonic_merge16_desc(top); }
        }
        float cv[16]; int ce[16];
#pragma unroll
        for (int i = 0; i < 16; ++i) { const int cc = 255 - (int)(top[i] & 255u), a = cc >> 4, b = cc & 15; cv[i] = tvl[a * 64] + tvl[(16 + b) * 64]; ce[i] = til[a * 64] * 128 + til[(16 + b) * 64]; }
        float mx = cv[0];
#pragma unroll
        for (int i = 1; i < 16; ++i) mx = fmaxf(mx, cv[i]);
        float ev[16], sm = 0.f;
#pragma unroll
        for (int i = 0; i < 16; ++i) { ev[i] = __expf(cv[i] - mx); sm += ev[i]; }
        const float inv = 1.f / sm;
        int* eo = (int*)(p->ws + WS_EID) + (size_t)tok * 128 + h * 16; float* go = (float*)(p->ws + WS_GW) + (size_t)tok * 128 + h * 16;
        if (sub == 0) {
#pragma unroll
            for (int j = 0; j < 4; ++j) { *(int4*)(eo + 4 * j) = make_int4(ce[4 * j], ce[4 * j + 1], ce[4 * j + 2], ce[4 * j + 3]);
                *(float4*)(go + 4 * j) = make_float4(ev[4 * j] * inv, ev[4 * j + 1] * inv, ev[4 * j + 2] * inv, ev[4 * j + 3] * inv); } }
    }
}

constexpr int PE_CHUNK = 8, PE_NCHUNK = MT / PE_CHUNK, PE_NSL = 8;
__device__ __forceinline__ unsigned wave_dequeue(unsigned* ctr, int lane) {
    unsigned v = 0u; if (lane == 0) v = __hip_atomic_fetch_add(ctr, 1u, __ATOMIC_RELAXED, __HIP_MEMORY_SCOPE_AGENT);
    return (unsigned)__builtin_amdgcn_readfirstlane((int)v);
}
constexpr int PEU_DQ = 2; constexpr int PEU_TOK = 4, PEU_NCHUNK = MT / PEU_TOK, PEU_XS = 1088, PEU_WL = 8192 + PEU_TOK * PEU_XS;
#define PEU_LOAD(ua_, j0_) do { \
    const int ia_ = (j0_) + q; const int ex_ = list[ia_ < n ? ia_ : n - 1] >> 9; \
    const unsigned char* ur_ = U8 + (size_t)ex_ * D + 16 * g; \
    _Pragma("unroll") for (int sp = 0; sp < 16; ++sp) ua_[sp] = *(const uint4*)(ur_ + 64 * sp); } while (0)
#define PEU_MMA(ua_, j0_) do { \
    const int ib_ = (j0_) + q; const int ic_ = ib_ < n ? ib_ : n - 1; const int ent_ = list[ic_]; \
    const unsigned char* xr_ = xl + ((ent_ >> 7) & 3) * PEU_XS + 16 * g; \
    f32x4 acc_ = {0.f, 0.f, 0.f, 0.f}; \
    _Pragma("unroll") for (int sp = 0; sp < 16; ++sp) { const uint4 xq_ = *(const uint4*)(xr_ + 64 * sp); \
        const long alo_ = (long)(((unsigned long long)ua_[sp].y << 32) | ua_[sp].x), ahi_ = (long)(((unsigned long long)ua_[sp].w << 32) | ua_[sp].z); \
        const long blo_ = (long)(((unsigned long long)xq_.y << 32) | xq_.x), bhi_ = (long)(((unsigned long long)xq_.w << 32) | xq_.z); \
        acc_ = __builtin_amdgcn_mfma_f32_16x16x32_fp8_fp8(alo_, blo_, acc_, 0, 0, 0); acc_ = __builtin_amdgcn_mfma_f32_16x16x32_fp8_fp8(ahi_, bhi_, acc_, 0, 0, 0); } \
      \
    const bool live_ = (g == (q >> 2)) && ib_ < n; \
    const float dsel_ = (q & 3) == 0 ? acc_[0] : ((q & 3) == 1 ? acc_[1] : ((q & 3) == 2 ? acc_[2] : acc_[3])); \
    const float dot_ = dsel_ * lsu[ic_]; \
    const float cf_ = lg[ic_] * 0.5f * dot_ * (1.f + erff(dot_ * 0.70710678118654752f)) * lsv[ic_]; \
    if (rep == 0) { if (live_) gw[(size_t)(rbeg + ((ent_ >> 7) & 3)) * 128 + (ent_ & 127)] = cf_; } else asm volatile("" :: "v"(cf_)); } while (0)
__device__ __forceinline__ void phase_peer_u(PP p, const Ctx& c, int layer, int rep) {
    const int lane = c.lane, g = lane >> 4, q = lane & 15; const unsigned char* U8 = p->ws + WS_U8 + (size_t)layer * NEXP * D; const unsigned char* X8 = p->ws + WS_X8;
    const float* sui = (const float*)(p->ws + WS_SUI) + (size_t)layer * NEXP; const float* svi = (const float*)(p->ws + WS_SVI) + (size_t)layer * NEXP;
    int* list = (int*)(c.lds + (size_t)c.wave * PEU_WL); float* lg = (float*)(list + 512); float* lsu = lg + 512; float* lsv = lsu + 512; unsigned char* xl = (unsigned char*)(list + 2048);
    const int* eid = (const int*)(p->ws + WS_EID); float* gw = (float*)(p->ws + WS_GW);
    const int xcc = (int)xb_xcc_id();
    for (int pass = 0; pass < PE_NSL; ++pass) {
        const int s = (xcc + pass) & (PE_NSL - 1);
        unsigned* ctr = (unsigned*)(p->ws + WS_CTR) + (size_t)(layer * CTR_PER_LAYER + rep * 40 + s) * 64;
        for (;;) {
            const unsigned chunk = wave_dequeue(ctr, lane); if (chunk >= (unsigned)(PEU_NCHUNK / PEU_DQ)) break;
            int en[8];
            { const size_t rb0 = (size_t)chunk * PEU_DQ * PEU_TOK;
#pragma unroll
              for (int t = 0; t < PEU_TOK; ++t) { en[2 * t] = eid[(rb0 + t) * 128 + lane]; en[2 * t + 1] = eid[(rb0 + t) * 128 + 64 + lane]; } }
            for (int sub = 0; sub < PEU_DQ; ++sub) {
            const int rbeg = ((int)chunk * PEU_DQ + sub) * PEU_TOK;
            const int e00 = en[0], e01 = en[1], e10 = en[2], e11 = en[3], e20 = en[4], e21 = en[5], e30 = en[6], e31 = en[7];
            { const size_t rbn = (size_t)(rbeg + PEU_TOK < MT ? rbeg + PEU_TOK : rbeg);
#pragma unroll
              for (int t = 0; t < PEU_TOK; ++t) { en[2 * t] = eid[(rbn + t) * 128 + lane]; en[2 * t + 1] = eid[(rbn + t) * 128 + 64 + lane]; } }
            const uint4 x0 = *(const uint4*)(X8 + (size_t)rbeg * D + lane * 16), x1 = *(const uint4*)(X8 + (size_t)(rbeg + 1) * D + lane * 16), x2 = *(const uint4*)(X8 + (size_t)(rbeg + 2) * D + lane * 16), x3 = *(const uint4*)(X8 + (size_t)(rbeg + 3) * D + lane * 16);
            WSYNC();
            *(uint4*)(xl + lane * 16) = x0; *(uint4*)(xl + PEU_XS + lane * 16) = x1; *(uint4*)(xl + 2 * PEU_XS + lane * 16) = x2; *(uint4*)(xl + 3 * PEU_XS + lane * 16) = x3;
            const int e[PEU_TOK][2] = {{e00, e01}, {e10, e11}, {e20, e21}, {e30, e31}};
            int n = 0;
#pragma unroll
            for (int t = 0; t < PEU_TOK; ++t) {
#pragma unroll
                for (int v = 0; v < 2; ++v) { const int ee = e[t][v]; const bool in = (ee >> 11) == s; const unsigned long long mk = __ballot(in);
                    if (in) { const int pos = n + lane_prefix(mk); list[pos] = (lane + 64 * v) | (t << 7) | (ee << 9); lg[pos] = gw[(size_t)(rbeg + t) * 128 + lane + 64 * v]; lsu[pos] = sui[ee]; lsv[pos] = svi[ee]; }
                    n += __popcll(mk); } }
            WSYNC();
            if (n == 0) continue;
#ifdef UPROBE_FRONT_ONLY
            if (rep != 0) { asm volatile("" :: "v"(n)); continue; }
#endif
            uint4 ua0[16], ua1[16];
            PEU_LOAD(ua0, 0);
            for (int j0 = 0; j0 < n; j0 += 32) {
                const bool has1 = j0 + 16 < n;
                if (has1) PEU_LOAD(ua1, j0 + 16);
                asm volatile("" ::: "memory");
                PEU_MMA(ua0, j0);
                if (has1) {
                    if (j0 + 32 < n) PEU_LOAD(ua0, j0 + 32);
                    asm volatile("" ::: "memory");
                    PEU_MMA(ua1, j0 + 16);
                }
            }
            }
        }
    }
}
#undef PEU_LOAD
#undef PEU_MMA
#define PEV_IDXE(ev_, r_) do { const int rr_ = (r_) < MT ? (r_) : MT - 1; _Pragma("unroll") for (int j = 0; j < 4; ++j) { const int4 e4 = *(const int4*)(eid + (size_t)rr_ * 128 + pg * 16 + j * 4); \
        ev_[j * 4] = e4.x; ev_[j * 4 + 1] = e4.y; ev_[j * 4 + 2] = e4.z; ev_[j * 4 + 3] = e4.w; } } while (0)
#define PEV_IDXC(cv_, r_) do { const int rr_ = (r_) < MT ? (r_) : MT - 1; _Pragma("unroll") for (int j = 0; j < 4; ++j) { const float4 c4 = *(const float4*)(gw + (size_t)rr_ * 128 + pg * 16 + j * 4); \
        cv_[j * 4] = c4.x; cv_[j * 4 + 1] = c4.y; cv_[j * 4 + 2] = c4.z; cv_[j * 4 + 3] = c4.w; } } while (0)
#define PEV_LOADV(vq_, ev_) do { _Pragma("unroll") for (int j = 0; j < 16; ++j) vq_[j] = *(const uint4*)(Vs + (size_t)ev_[j] * 128); } while (0)
#define PEV_FINISH(vq_, cv_, r_) do { \
    float* xr_ = p->out + (size_t)(r_) * D + s * 128 + ch * 16 + ((lane >> 5) & 1) * 8 + ((lane >> 4) & 1) * 4 + ((lane >> 3) & 1) * 2; const float2 xold_ = *(const float2*)xr_; \
    float acc[16]; \
    _Pragma("unroll") for (int e = 0; e < 16; ++e) acc[e] = 0.f; \
    _Pragma("unroll") for (int j = 0; j < 16; ++j) { const unsigned w4[4] = {vq_[j].x, vq_[j].y, vq_[j].z, vq_[j].w}; \
        _Pragma("unroll") for (int k = 0; k < 4; ++k) { const f32x2v lo = __builtin_amdgcn_cvt_pk_f32_fp8((int)w4[k], false), hi = __builtin_amdgcn_cvt_pk_f32_fp8((int)w4[k], true); \
            acc[4 * k] += cv_[j] * lo.x; acc[4 * k + 1] += cv_[j] * lo.y; acc[4 * k + 2] += cv_[j] * hi.x; acc[4 * k + 3] += cv_[j] * hi.y; } \
        if ((j & 1) == 1) asm volatile("" : "+v"(acc[0]), "+v"(acc[1]), "+v"(acc[2]), "+v"(acc[3]), "+v"(acc[4]), "+v"(acc[5]), "+v"(acc[6]), "+v"(acc[7]), "+v"(acc[8]), "+v"(acc[9]), "+v"(acc[10]), "+v"(acc[11]), "+v"(acc[12]), "+v"(acc[13]), "+v"(acc[14]), "+v"(acc[15])); } \
    { const bool hi = (lane & 32) != 0; _Pragma("unroll") for (int k = 0; k < 8; ++k) { const float snd = hi ? acc[k] : acc[k + 8]; const float rcv = __shfl_xor(snd, 32); acc[k] = (hi ? acc[k + 8] : acc[k]) + rcv; } } \
    { const bool hi = (lane & 16) != 0; _Pragma("unroll") for (int k = 0; k < 4; ++k) { const float snd = hi ? acc[k] : acc[k + 4]; const float rcv = __shfl_xor(snd, 16); acc[k] = (hi ? acc[k + 4] : acc[k]) + rcv; } } \
    { const bool hi = (lane & 8) != 0; _Pragma("unroll") for (int k = 0; k < 2; ++k) { const float snd = hi ? acc[k] : acc[k + 2]; const float rcv = __shfl_xor(snd, 8); acc[k] = (hi ? acc[k + 2] : acc[k]) + rcv; } } \
    if (rep != 0) { asm volatile("" :: "v"(acc[0]), "v"(acc[1]), "v"(xold_.x)); } else { *(float2*)xr_ = make_float2(xold_.x + acc[0], xold_.y + acc[1]); } } while (0)
__device__ __forceinline__ void phase_peer_v(PP p, const Ctx& c, int layer, int rep) {
    const int lane = c.lane, pg = lane >> 3, ch = lane & 7; const unsigned char* V8 = p->ws + WS_V8 + (size_t)layer * NEXP * D;
    const int* eid = (const int*)(p->ws + WS_EID); const float* gw = (const float*)(p->ws + WS_GW);
    const int xcc = (int)xb_xcc_id();
    for (int pass = 0; pass < PE_NSL; ++pass) {
        const int s = (xcc + pass) & (PE_NSL - 1);
        unsigned* ctr = (unsigned*)(p->ws + WS_CTR) + (size_t)(layer * CTR_PER_LAYER + rep * 40 + 16 + s) * 64;
        for (;;) {
            const unsigned chunk = wave_dequeue(ctr, lane); if (chunk >= (unsigned)PE_NCHUNK) break;
            const unsigned char* Vs = V8 + (size_t)s * NEXP * 128 + ch * 16;
            const int rbeg = (int)chunk * PE_CHUNK;
            int evA[16], evB[16]; float cvA[16], cvB[16]; uint4 vqA[16], vqB[16];
            PEV_IDXE(evA, rbeg); PEV_IDXC(cvA, rbeg); PEV_IDXE(evB, rbeg + 1); PEV_IDXC(cvB, rbeg + 1);
            PEV_LOADV(vqA, evA);
            PEV_IDXE(evA, rbeg + 2);
            for (int r = rbeg; r < rbeg + PE_CHUNK; r += 2) {
                PEV_LOADV(vqB, evB); PEV_IDXE(evB, r + 3);
                asm volatile("" ::: "memory");
                PEV_FINISH(vqA, cvA, r);
                PEV_IDXC(cvA, r + 2);
                if (r + 2 < rbeg + PE_CHUNK) { PEV_LOADV(vqA, evA); PEV_IDXE(evA, r + 4); }
                asm volatile("" ::: "memory");
                PEV_FINISH(vqB, cvB, r + 1);
                PEV_IDXC(cvB, r + 3);
            }
        }
    }
}
#undef PEV_IDXE
#undef PEV_IDXC
#undef PEV_LOADV
#undef PEV_FINISH

struct EPraw { unsigned char* ws; float* out; int layer;
    __device__ __forceinline__ void vt_store(bf16_t* base  , int pitch, int cc, int pos, f32x4 v) const {
        const int o16 = pos & 15, pp = (pos & ~15) + 8 * ((o16 >> 2) & 1) + 4 * (o16 >> 3) + (o16 & 3);
#pragma unroll
        for (int i = 0; i < 4; ++i) base[(size_t)(cc + i) * pitch + pp] = f2bf(v[i]); }
    __device__ __forceinline__ void store4(int row, int col, f32x4 v) const {
        if (col >= C_GA) { if (col >= C_GA + 2 * D) return;
            u32x2v w; w.x = pk2bf(__builtin_amdgcn_rcpf(1.f + __expf(-v[0])), __builtin_amdgcn_rcpf(1.f + __expf(-v[1]))); w.y = pk2bf(__builtin_amdgcn_rcpf(1.f + __expf(-v[2])), __builtin_amdgcn_rcpf(1.f + __expf(-v[3])));
            bf16_t* dst = col >= C_GB ? (bf16_t*)(ws + WS_SGB) + (size_t)row * D + (col - C_GB) : (bf16_t*)(ws + WS_SGA) + (size_t)row * D + (col - C_GA); *(u32x2v*)dst = w; return; }
        u32x2v w; w.x = pk2bf(v[0], v[1]); w.y = pk2bf(v[2], v[3]);
        const bool samp = row >= MP; const int rs = row - MP;
        if (col >= C_QB) {
            if (col < C_KB) { *(u32x2v*)((bf16_t*)(ws + WS_QB) + (size_t)row * 512 + (col - C_QB)) = w; return; }
            if (col < C_VB) { const int cc = col - C_KB;
                *(f32x4*)(out + (samp ? O_BKS + ((size_t)layer * MS + rs) * 512 : O_BKP + ((size_t)layer * MP + row) * 512) + cc) = v;
                *(u32x2v*)((samp ? (bf16_t*)(ws + WS_KBS) + ((size_t)(layer * NB + (rs >> 4)) * SBL + SBT + (rs & 15)) * 512 : (bf16_t*)(ws + WS_KBP) + (size_t)row * 512) + cc) = w; return; }
            const int cc = col - C_VB;
            *(f32x4*)(out + (samp ? O_BVS + ((size_t)layer * MS + rs) * 512 : O_BVP + ((size_t)layer * MP + row) * 512) + cc) = v;
            if (samp) vt_store((bf16_t*)(ws + WS_VBTS) + (size_t)(layer * NB + (rs >> 4)) * 8 * 64 * SBL, SBL, cc, SBT + (rs & 15), v); else vt_store((bf16_t*)(ws + WS_VBT) + (size_t)(row >> 11) * 8 * 64 * SEQ, SEQ, cc, row & 2047, v);
            return;
        }
        if (col >= C_VA && col < C_QI) { const int cc = col - C_VA;
            *(f32x4*)(out + (samp ? O_AVS + ((size_t)layer * MS + rs) * 128 : O_AVP + ((size_t)layer * MP + row) * 128) + cc) = v;
            if (samp) vt_store((bf16_t*)(ws + WS_VATS) + (size_t)(layer * NB + (rs >> 4)) * 2 * 64 * SKP, SKP, cc, PAST + (rs & 15), v); else vt_store((bf16_t*)(ws + WS_VAT) + (size_t)(row >> 11) * 2 * 64 * SEQ, SEQ, cc, row & 2047, v);
            return; }
        *(u32x2v*)((bf16_t*)(ws + WS_PRAW) + (size_t)row * NINP + col) = w; }
    __device__ __forceinline__ void store8(int row, int col, f32x4 v0, f32x4 v1) const {
        if (col >= C_GA) { if (col >= C_GA + 2 * D) return;
            uint4 w; w.x = pk2bf(__builtin_amdgcn_rcpf(1.f + __expf(-v0[0])), __builtin_amdgcn_rcpf(1.f + __expf(-v0[1]))); w.y = pk2bf(__builtin_amdgcn_rcpf(1.f + __expf(-v0[2])), __builtin_amdgcn_rcpf(1.f + __expf(-v0[3])));
            w.z = pk2bf(__builtin_amdgcn_rcpf(1.f + __expf(-v1[0])), __builtin_amdgcn_rcpf(1.f + __expf(-v1[1]))); w.w = pk2bf(__builtin_amdgcn_rcpf(1.f + __expf(-v1[2])), __builtin_amdgcn_rcpf(1.f + __expf(-v1[3])));
            bf16_t* dst = col >= C_GB ? (bf16_t*)(ws + WS_SGB) + (size_t)row * D + (col - C_GB) : (bf16_t*)(ws + WS_SGA) + (size_t)row * D + (col - C_GA); *(uint4*)dst = w; return; }
        store4(row, col, v0); store4(row, col + 4, v1); } };
struct EGate { bf16_t* o; const bf16_t* g; const bf16_t* add;
    __device__ __forceinline__ void store4(int row, int col, f32x4 v) const { const size_t i = (size_t)row * D + col; const u32x2v gw = *(const u32x2v*)(g + i);
        float r0 = __uint_as_float(gw.x << 16) * v[0], r1 = __uint_as_float(gw.x & 0xFFFF0000u) * v[1], r2 = __uint_as_float(gw.y << 16) * v[2], r3 = __uint_as_float(gw.y & 0xFFFF0000u) * v[3];
        if (add) { const u32x2v aw = *(const u32x2v*)(add + i); r0 += __uint_as_float(aw.x << 16); r1 += __uint_as_float(aw.x & 0xFFFF0000u); r2 += __uint_as_float(aw.y << 16); r3 += __uint_as_float(aw.y & 0xFFFF0000u); }
        u32x2v w; w.x = pk2bf(r0, r1); w.y = pk2bf(r2, r3); *(u32x2v*)(o + i) = w; }
    __device__ __forceinline__ void store8(int row, int col, f32x4 v0, f32x4 v1) const { const size_t i = (size_t)row * D + col; const uint4 gq = *(const uint4*)(g + i);
        float r[8] = {__uint_as_float(gq.x << 16) * v0[0], __uint_as_float(gq.x & 0xFFFF0000u) * v0[1], __uint_as_float(gq.y << 16) * v0[2], __uint_as_float(gq.y & 0xFFFF0000u) * v0[3],
                      __uint_as_float(gq.z << 16) * v1[0], __uint_as_float(gq.z & 0xFFFF0000u) * v1[1], __uint_as_float(gq.w << 16) * v1[2], __uint_as_float(gq.w & 0xFFFF0000u) * v1[3]};
        if (add) { const uint4 aq = *(const uint4*)(add + i); r[0] += __uint_as_float(aq.x << 16); r[1] += __uint_as_float(aq.x & 0xFFFF0000u); r[2] += __uint_as_float(aq.y << 16); r[3] += __uint_as_float(aq.y & 0xFFFF0000u);
            r[4] += __uint_as_float(aq.z << 16); r[5] += __uint_as_float(aq.z & 0xFFFF0000u); r[6] += __uint_as_float(aq.w << 16); r[7] += __uint_as_float(aq.w & 0xFFFF0000u); }
        uint4 w; w.x = pk2bf(r[0], r[1]); w.y = pk2bf(r[2], r[3]); w.z = pk2bf(r[4], r[5]); w.w = pk2bf(r[6], r[7]); *(uint4*)(o + i) = w; } };
struct EResid { float* x; __device__ __forceinline__ void store4(int row, int col, f32x4 v) const { f32x4* q = (f32x4*)(x + (size_t)row * D + col); *q = *q + v; } };
struct EScoreT { float* s; __device__ __forceinline__ void store4(int row  , int col  , f32x4 v) const {
#pragma unroll
        for (int i = 0; i < 4; ++i) s[(size_t)(col + i) * MT + row] = v[i]; }
    __device__ __forceinline__ void storeN(int n, int tok, f32x4 v) const { *(f32x4*)(s + (size_t)n * MT + tok) = v; } };

template <class F> struct EpiAdapt { static constexpr bool PERM = false, AFTER_DRAIN = false; F f;
    __device__ __forceinline__ void operator()(const f32x4 (&acc)[2][2][4][2], const pg8::Unit& u, int wr, int wc, int fr, int fq) const {
        const int row0 = u.pm * 256 + wr * 64 + fr, col0 = u.pn * 256 + wc * 32 + 4 * fq;
#pragma unroll
        for (int ai = 0; ai < 2; ++ai)
#pragma unroll
            for (int m = 0; m < 4; ++m)
#pragma unroll
                for (int bj = 0; bj < 2; ++bj)
#pragma unroll
                    for (int n = 0; n < 2; ++n) f.store4(row0 + ai * 128 + m * 16, col0 + bj * 128 + n * 16, acc[ai][bj][m][n]);
    } };

template <class F> __device__ __forceinline__ void small_gemm(const Ctx& c, const bf16_t* A, const bf16_t* Bt, int N, int K, const F& f) {
    const int ntasks = (N / 16) * 8, lane = c.lane;
    for (int task = c.gwave; task < ntasks; task += c.nwaves) {
        const int tn = task >> 3, tm = task & 7;
        const bf16_t* ap = A + (size_t)(MP + tm * 16 + (lane & 15)) * K + (lane >> 4) * 8; const bf16_t* bp = Bt + (size_t)(tn * 16 + (lane & 15)) * K + (lane >> 4) * 8;
        f32x4 acc = {0.f, 0.f, 0.f, 0.f};
#pragma unroll 1
        for (int k = 0; k < K; k += 512) { bf16x8 a[16], b[16];
#pragma unroll
            for (int i = 0; i < 16; ++i) { a[i] = *(const bf16x8*)(ap + k + 32 * i); b[i] = *(const bf16x8*)(bp + k + 32 * i); }
            asm volatile("" ::: "memory");
#pragma unroll
            for (int i = 0; i < 16; ++i) acc = __builtin_amdgcn_mfma_f32_16x16x32_bf16(b[i], a[i], acc, 0, 0, 0); }
        f.store4(MP + tm * 16 + (lane & 15), tn * 16 + (lane >> 4) * 4, acc);
    }
}
template <class F> struct EpiAdaptT { static constexpr bool PERM = false, AFTER_DRAIN = false; F f;
    __device__ __forceinline__ void operator()(const f32x4 (&acc)[2][2][4][2], const pg8::Unit& u, int wr, int wc, int fr, int fq) const {
        const int row0 = u.pm * 256 + wr * 64 + fr, col0 = u.pn * 256 + wc * 32 + 4 * fq;
#pragma unroll
        for (int ai = 0; ai < 2; ++ai)
#pragma unroll
            for (int mm = 0; mm < 4; ++mm)
#pragma unroll
                for (int bj = 0; bj < 2; ++bj)
#pragma unroll
                    for (int n = 0; n < 2; ++n) f.storeN(row0 + ai * 128 + mm * 16, col0 + bj * 128 + n * 16, acc[ai][bj][mm][n]);
    } };
struct OneUnit { int pm, pn; bool has;
    __device__ __forceinline__ bool next(int i, pg8::Unit& u) const { if (i != 0 || !has) return false; u.pm = pm; u.pn = pn; return true; }
    __device__ __forceinline__ void a_ready(const pg8::Unit&) const {}
    __device__ __forceinline__ void done(const pg8::Unit&) const {} };
#define SEL_RD(k_) L[(k_) * 256 + (t ^ (((k_) & 15) << 2))]
#define SEL_STAGE_A(side_) do { unsigned top[16]; \
    _Pragma("unroll") for (int kh = 0; kh < 128; kh += 64) { float v[64]; \
        _Pragma("unroll") for (int k = 0; k < 64; ++k) v[k] = SEL_RD(kh + k); \
        _Pragma("unroll") for (int g = 0; g < 4; ++g) { unsigned s[16]; \
            _Pragma("unroll") for (int i = 0; i < 16; ++i) s[i] = (fkey(v[g * 16 + i]) & ~127u) | (unsigned)(127 - kh - g * 16 - i); \
            if (kh == 0 && g == 0) { bitonic_sort16<true>(s); _Pragma("unroll") for (int i = 0; i < 16; ++i) top[i] = s[i]; } \
            else { bitonic_sort16<false>(s); _Pragma("unroll") for (int i = 0; i < 16; ++i) top[i] = __builtin_elementwise_max(top[i], s[i]); bitonic_merge16_desc(top); } } } \
    _Pragma("unroll") for (int i = 0; i < 16; ++i) { const int k = 127 - (int)(top[i] & 127u); ti[side_][i] = k; tv[side_][i] = SEL_RD(k); } } while (0)
struct EpiSel { static constexpr bool PERM = false, AFTER_DRAIN = true; unsigned char* ws; int tile;
    __device__ __forceinline__ void fused(const f32x4 (&acc)[2][2][4][2], const pg8::Unit& u, int wr, int wc, int fr, int fq, PG8_LAS unsigned char* ldsb, int wid, int lane) const {
        float* L = (float*)ldsb; const int t = wid * 64 + lane;
#pragma unroll
        for (int mm = 0; mm < 4; ++mm)
#pragma unroll
            for (int bj = 0; bj < 2; ++bj)
#pragma unroll
                for (int n = 0; n < 2; ++n) { const int k = 64 * wr + 16 * mm + fr, col = 128 * bj + 32 * wc + 16 * n + 4 * fq;
                    *(f32x4*)(L + k * 256 + (col ^ ((k & 15) << 2))) = acc[0][bj][mm][n]; }
        __syncthreads();
        float tv[2][16]; int ti[2][16];
        if (t < 256) SEL_STAGE_A(0);
        __syncthreads();
#pragma unroll
        for (int mm = 0; mm < 4; ++mm)
#pragma unroll
            for (int bj = 0; bj < 2; ++bj)
#pragma unroll
                for (int n = 0; n < 2; ++n) { const int k = 64 * wr + 16 * mm + fr, col = 128 * bj + 32 * wc + 16 * n + 4 * fq;
                    *(f32x4*)(L + k * 256 + (col ^ ((k & 15) << 2))) = acc[1][bj][mm][n]; }
        __syncthreads();
        if (t < 256) SEL_STAGE_A(1);
        __syncthreads();
        if (t < 256) {
            float* tvl = L + t; int* til = (int*)L + 32 * 256 + t;
#pragma unroll
            for (int sd = 0; sd < 2; ++sd)
#pragma unroll
                for (int i = 0; i < 16; ++i) { tvl[(sd * 16 + i) * 256] = tv[sd][i]; til[(sd * 16 + i) * 256] = ti[sd][i]; }
            unsigned top[16];
#pragma unroll
            for (int g = 0; g < 4; ++g) {
                unsigned s[16];
#pragma unroll
                for (int i = 0; i < 16; ++i) s[i] = 0u;
                { int cnt = 0;
#pragma unroll
                  for (int a = 0; a < 16; ++a)
#pragma unroll
                    for (int b = 0; b < 16; ++b) if ((a + 1) * (b + 1) <= 16) { if (cnt / 16 == g) s[cnt % 16] = (fkey(tv[0][a] + tv[1][b]) & ~255u) | (unsigned)(255 - (a * 16 + b)); ++cnt; } }
                if (g == 0) { bitonic_sort16<true>(s);
#pragma unroll
                    for (int i = 0; i < 16; ++i) top[i] = s[i]; }
                else { bitonic_sort16<false>(s);
#pragma unroll
                    for (int i = 0; i < 16; ++i) top[i] = __builtin_elementwise_max(top[i], s[i]);
                    bitonic_merge16_desc(top); }
            }
            float cv[16]; int ce[16];
#pragma unroll
            for (int i = 0; i < 16; ++i) { const int cc = 255 - (int)(top[i] & 255u), a = cc >> 4, b = cc & 15; cv[i] = tvl[a * 256] + tvl[(16 + b) * 256]; ce[i] = til[a * 256] * 128 + til[(16 + b) * 256]; }
            float mx = cv[0];
#pragma unroll
            for (int i = 1; i < 16; ++i) mx = fmaxf(mx, cv[i]);
            float ev[16], sm = 0.f;
#pragma unroll
            for (int i = 0; i < 16; ++i) { ev[i] = __expf(cv[i] - mx); sm += ev[i]; }
            const float inv = 1.f / sm; const size_t tok = (size_t)u.pn * 256 + t;
            int* eo = (int*)(ws + WS_EID) + tok * 128 + u.pm * 16; float* go = (float*)(ws + WS_GW) + tok * 128 + u.pm * 16;
#pragma unroll
            for (int j = 0; j < 4; ++j) { *(int4*)(eo + 4 * j) = make_int4(ce[4 * j], ce[4 * j + 1], ce[4 * j + 2], ce[4 * j + 3]);
                *(float4*)(go + 4 * j) = make_float4(ev[4 * j] * inv, ev[4 * j + 1] * inv, ev[4 * j + 2] * inv, ev[4 * j + 3] * inv); }
        }
        __syncthreads();
    } };
#undef SEL_RD
#undef SEL_STAGE_A
template <class F> __device__ __forceinline__ void gemm_scores_select(const Ctx& c, unsigned char* ws, const bf16_t* H, const bf16_t* Wpk, const F& fsample) {
    pg8::Gemm g{Wpk, H, 2048, MP, D};
    { const int U = c.bid; OneUnit S{U & 7, U >> 3, U < 256}; EpiSel E{ws, U & 255}; pg8::gemm_phase<EpiSel, OneUnit, false>((PG8_LAS unsigned char*)c.lds, g, S, E, nullptr); }
    { const int U = 256 + c.bid; OneUnit S{U & 7, U >> 3, U < 512}; EpiSel E{ws, 256 + (c.bid & 255)}; pg8::gemm_phase<EpiSel, OneUnit, false>((PG8_LAS unsigned char*)c.lds, g, S, E, nullptr); }
    small_gemm(c, H, Wpk, 2048, D, fsample);
}
template <class F> struct EpiAdaptP { static constexpr bool PERM = true, AFTER_DRAIN = false; F f;
    __device__ __forceinline__ void operator()(const f32x4 (&acc)[2][2][4][2], const pg8::Unit& u, int wr, int wc, int fr, int fq) const {
        const int row0 = u.pm * 256 + wr * 64 + fr, col0 = u.pn * 256 + wc * 32 + 8 * fq;
#pragma unroll
        for (int ai = 0; ai < 2; ++ai)
#pragma unroll
            for (int mm = 0; mm < 4; ++mm)
#pragma unroll
                for (int bj = 0; bj < 2; ++bj) f.store8(row0 + ai * 128 + mm * 16, col0 + bj * 128, acc[ai][bj][mm][0], acc[ai][bj][mm][1]);
    } };
template <class F> __device__ __forceinline__ void gemm_both8(const Ctx& c, const bf16_t* A, const bf16_t* Bt, int N, int K, const F& f) {
    pg8::Gemm g{A, Bt, MP, N, K}; pg8::StaticOrder S; S.init(MP, N, c.G, c.bid); EpiAdaptP<F> E{f};
    pg8::gemm_phase<EpiAdaptP<F>, pg8::StaticOrder, false>((PG8_LAS unsigned char*)c.lds, g, S, E, nullptr);
    small_gemm(c, A, Bt, N, K, f);
}
template <class F> __device__ __forceinline__ void gemm_both(const Ctx& c, const bf16_t* A, const bf16_t* Bt, int N, int K, const F& f) {
    pg8::Gemm g{A, Bt, MP, N, K}; pg8::StaticOrder S; S.init(MP, N, c.G, c.bid); EpiAdapt<F> E{f};
    pg8::gemm_phase<EpiAdapt<F>, pg8::StaticOrder, false>((PG8_LAS unsigned char*)c.lds, g, S, E, nullptr);
    small_gemm(c, A, Bt, N, K, f);
}

constexpr int NPH = 12;
constexpr int NSTEPS = 1 + DEPTH * NPH;
constexpr int LDS_STAGE = 131072, LDS_BYTES = LDS_STAGE + 256;

template <int layer> __device__ __forceinline__ void layer_steps(const int lo, const int hi, const XcdBarrier& bar, unsigned char* shm) {
#define KP kargs()
#ifndef PHMASK
#define PHMASK 0xFFFF
#endif
#define IN(k) (lo <= (k) && (k) < hi)
#define ON(b) ((PHMASK >> (b)) & 1)
#ifndef BARX
#define BARX 1
#endif
#define SEAM(k) do { if (IN(k) && IN((k) + 1)) { for (int bx_ = 0; bx_ < BARX; ++bx_) xcd_barrier(bar); } } while (0)
#ifndef REPPH
#define REPPH -1
#define REPN 1
#endif
#define REPEAT(k) for (int rep_ = 0; rep_ < ((REPPH) == (k) ? (REPN) : 1); ++rep_)
        const int s0 = 1 + layer * NPH;
        if (ON(0) && IN(s0 + 0)) REPEAT(0) { phase_rms(KP, mkctx(shm), KP->norm1 + layer * D, layer == 0); }
        SEAM(s0 + 0);
        if (ON(1) && IN(s0 + 1)) REPEAT(1) { gemm_both8(mkctx(shm), (const bf16_t*)(KP->ws + WS_H), (const bf16_t*)(KP->ws + WS_WIN) + (size_t)layer * NINP * D, NINP, D, EPraw{KP->ws, KP->out, layer}); }
        SEAM(s0 + 1);
        if (ON(2) && IN(s0 + 2)) REPEAT(2) { phase_post(KP, mkctx(shm), layer); }
        SEAM(s0 + 2);
        if (ON(3) && IN(s0 + 3)) { REPEAT(13) { phase_sb_mfma(KP, mkctx(shm), layer); } __syncthreads(); REPEAT(3) { phase_dsa_select(KP, mkctx(shm), layer, rep_); } }
        SEAM(s0 + 3);
        if (ON(4) && IN(s0 + 4)) REPEAT(4) { phase_dsa_attn(KP, mkctx(shm), layer, rep_); }
        SEAM(s0 + 4);
        if (ON(5) && IN(s0 + 5)) REPEAT(5) { gemm_both8(mkctx(shm), (const bf16_t*)(KP->ws + WS_OA), (const bf16_t*)(KP->ws + WS_WPA) + (size_t)layer * D * 512, D, 512, EGate{(bf16_t*)(KP->ws + WS_T), (const bf16_t*)(KP->ws + WS_SGA), nullptr});
            asm volatile("s_waitcnt vmcnt(0)" ::: "memory"); __syncthreads();
            gemm_both8(mkctx(shm), (const bf16_t*)(KP->ws + WS_OB), (const bf16_t*)(KP->ws + WS_WPB) + (size_t)layer * D * 512, D, 512, EGate{(bf16_t*)(KP->ws + WS_M), (const bf16_t*)(KP->ws + WS_SGB), (const bf16_t*)(KP->ws + WS_T)}); }
        SEAM(s0 + 5);
        if (ON(7) && IN(s0 + 6)) REPEAT(7) { gemm_both(mkctx(shm), (const bf16_t*)(KP->ws + WS_M), (const bf16_t*)(KP->ws + WS_WO) + (size_t)layer * D * D, D, D, EResid{KP->out}); }
        SEAM(s0 + 6);
        if (ON(8) && IN(s0 + 7)) REPEAT(8) { phase_rms(KP, mkctx(shm), KP->norm2 + layer * D, false); }
        SEAM(s0 + 7);
        if (ON(9) && IN(s0 + 8)) REPEAT(9) { gemm_scores_select(mkctx(shm), KP->ws, (const bf16_t*)(KP->ws + WS_H), (const bf16_t*)(KP->ws + WS_WPK) + (size_t)layer * 2048 * D, EScoreT{(float*)(KP->ws + WS_PRAW)}); }
        SEAM(s0 + 8);
        if (ON(10) && IN(s0 + 9)) REPEAT(10) { phase_peer_select(KP, mkctx(shm)); }
        SEAM(s0 + 9);
        if (ON(11) && IN(s0 + 10)) REPEAT(11) { phase_peer_u(KP, mkctx(shm), layer, rep_); }
        SEAM(s0 + 10);
        if (ON(13) && IN(s0 + 11)) REPEAT(12) { phase_peer_v(KP, mkctx(shm), layer, rep_); }
        SEAM(s0 + 11);
#undef KP
#undef IN
#undef ON
#undef SEAM
#undef REPEAT
}

__global__ void __launch_bounds__(512, 2) k_fwd(const Params p_unused) {
    extern __shared__ __attribute__((aligned(16))) unsigned char shm[];
    volatile LAS unsigned* xbw = (volatile LAS unsigned*)(shm + LDS_STAGE);
    if (threadIdx.x < 4) xbw[threadIdx.x] = 0u;
    __syncthreads();
#define KP kargs()
    const int lo = KP->ph_lo, hi = KP->ph_hi;
    XcdBarrier bar; bar.bar = (unsigned*)(KP->ws + WS_BAR); bar.x = 0; bar.st = xbw;
    if (hi - lo > 1) bar = xcd_barrier_post((unsigned*)(KP->ws + WS_BAR), xbw);
#ifndef PHMASK
#define PHMASK 0xFFFF
#endif
#define IN(k) (lo <= (k) && (k) < hi)
#define ON(b) ((PHMASK >> (b)) & 1)
#ifndef BARX
#define BARX 1
#endif
#define SEAM(k) do { if (IN(k) && IN((k) + 1)) { for (int bx_ = 0; bx_ < BARX; ++bx_) xcd_barrier(bar); } } while (0)
#ifndef REPPH
#define REPPH -1
#define REPN 1
#endif
    if (ON(12) && IN(0)) for (int rep_ = 0; rep_ < ((REPPH) == 20 ? (REPN) : 1); ++rep_) { phase_prologue(KP, mkctx(shm)); }
    SEAM(0);
    layer_steps<0>(lo, hi, bar, shm); layer_steps<1>(lo, hi, bar, shm); layer_steps<2>(lo, hi, bar, shm); layer_steps<3>(lo, hi, bar, shm);
#undef IN
#undef KP
#undef SEAM
}
}

#ifndef MK_ONE_LAUNCH
#define MK_ONE_LAUNCH 1
#endif

extern "C" void kernel_launch(void* const* d_in, const int* in_sizes, int n_in, void* d_out, int out_size, void* d_ws, size_t ws_size, hipStream_t stream) {
    using namespace mk;
    static int grid = 0;
    if (grid == 0) {
        if (n_in != 21 || (size_t)out_size != O_END || ws_size < WS_END) { fprintf(stderr, "kernel_launch: unexpected sizes: n_in %d out %d (want %zu) ws %zu (want %zu)\n", n_in, out_size, O_END, ws_size, WS_END); grid = -1; return; }
        if (hipFuncSetAttribute((const void*)k_fwd, hipFuncAttributeMaxDynamicSharedMemorySize, LDS_BYTES) != hipSuccess) { fprintf(stderr, "kernel_launch: hipFuncSetAttribute failed\n"); grid = -1; return; }
        int dev = 0, cus = 0, per_cu = 0;
        if (hipGetDevice(&dev) != hipSuccess || hipDeviceGetAttribute(&cus, hipDeviceAttributeMultiprocessorCount, dev) != hipSuccess) { grid = -1; return; }
        if (hipOccupancyMaxActiveBlocksPerMultiprocessor(&per_cu, (const void*)k_fwd, 512, LDS_BYTES) != hipSuccess || per_cu < 1) { fprintf(stderr, "kernel_launch: occupancy query says %d\n", per_cu); (void)hipGetLastError(); }
        grid = cus;
        if (grid != 256) { fprintf(stderr, "kernel_launch: built for a 256-CU device (two score-GEMM units per workgroup); this device reports %d CUs: nothing launched\n", cus); grid = -1; return; }
    }
    if (grid < 0) return;
    (void)hipMemsetAsync((char*)d_ws + WS_BAR, 0, WS_ZERO_BYTES, stream);
    Params p{};
    const float** pp = (const float**)&p;
    for (int i = 0; i < 21; ++i) pp[i] = (const float*)d_in[i];
    p.out = (float*)d_out; p.ws = (unsigned char*)d_ws;
#if MK_ONE_LAUNCH
    p.ph_lo = 0; p.ph_hi = NSTEPS;
    hipLaunchKernelGGL(k_fwd, dim3(grid), dim3(512), LDS_BYTES, stream, p);
#else
    for (int s = 0; s < NSTEPS; ++s) { p.ph_lo = s; p.ph_hi = s + 1; hipLaunchKernelGGL(k_fwd, dim3(grid), dim3(512), LDS_BYTES, stream, p); }
#endif
}
```
